# Optimizing an MI355X kernel written in HIP

```python
import jax, jax.numpy as jnp
from jax import lax
import numpy as np

D_MODEL = 1024
BATCH = 4
SEQ = 8192
DEPTH = 4

CHUNK = 64
N_MIXERS = 2
POOL_WINDOWS = (2, 4, 8, 16)
POOL_GROUPS = len(POOL_WINDOWS)
POOL_GW = D_MODEL // POOL_GROUPS
N_HEADS = 16
HEAD_DIM = D_MODEL // N_HEADS
LEFT_CHUNKS = 8
BAND_CHUNKS = LEFT_CHUNKS + 1
BAND = BAND_CHUNKS * CHUNK
REL_CLIP = 256
D_FF = 2816
CONV_W = 3
N_A = (DEPTH + 1) // 2
N_B = DEPTH // 2
EPS = 1e-6

kernel_name = "hybrid_pool_chunkattn_convffn"


def rmsnorm(x, g):
    xf = x.astype(jnp.float32)
    y = xf * lax.rsqrt(jnp.mean(xf * xf, axis=-1, keepdims=True) + EPS)
    return (y * g.astype(jnp.float32)).astype(x.dtype)


def pool_mixer(h, w_pool, b_pool, scale):
    B, S, D = h.shape
    hf = h.astype(jnp.float32)
    csp = jnp.concatenate([jnp.zeros((B, 1, D), jnp.float32), jnp.cumsum(hf, axis=1)], axis=1)
    t = jnp.arange(S)
    outs = []
    for g, w in enumerate(POOL_WINDOWS):
        c = csp[:, :, g * POOL_GW:(g + 1) * POOL_GW]
        upper = c[:, 1:]
        lower = jnp.concatenate([jnp.zeros((B, w - 1, POOL_GW), jnp.float32), c[:, :S - w + 1]], axis=1)
        cnt = jnp.minimum(t + 1, w).astype(jnp.float32)[None, :, None]
        outs.append((upper - lower) / cnt)
    pooled = jnp.concatenate(outs, axis=-1)
    y = (pooled - hf).astype(h.dtype).reshape(B, S, POOL_GROUPS, POOL_GW)
    y = jnp.einsum('bsgc,gcd->bsgd', y, w_pool).reshape(B, S, D) + b_pool
    return y * scale


def head_rmsnorm(x, g):
    xf = x.astype(jnp.float32)
    y = xf * lax.rsqrt(jnp.mean(xf * xf, axis=-1, keepdims=True) + EPS)
    return (y * g.astype(jnp.float32)).astype(x.dtype)


def chunk_attention(h, w_qkv, q_norm, k_norm, rel_table, w_o):
    B, S, D = h.shape
    nc = S // CHUNK
    qkv = h @ w_qkv
    q, k, v = jnp.split(qkv, 3, axis=-1)
    q = head_rmsnorm(q.reshape(B, S, N_HEADS, HEAD_DIM), q_norm)
    k = head_rmsnorm(k.reshape(B, S, N_HEADS, HEAD_DIM), k_norm)
    v = v.reshape(B, S, N_HEADS, HEAD_DIM)
    q = q.reshape(B, nc, CHUNK, N_HEADS, HEAD_DIM)
    pad = jnp.zeros((B, LEFT_CHUNKS, CHUNK, N_HEADS, HEAD_DIM), k.dtype)
    kp = jnp.concatenate([pad, k.reshape(B, nc, CHUNK, N_HEADS, HEAD_DIM)], axis=1)
    vp = jnp.concatenate([pad, v.reshape(B, nc, CHUNK, N_HEADS, HEAD_DIM)], axis=1)
    rel = jnp.arange(CHUNK)[:, None] - jnp.arange(BAND)[None, :] + LEFT_CHUNKS * CHUNK
    idx = jnp.clip(rel, -REL_CLIP, REL_CLIP) + REL_CLIP
    bias = rel_table.astype(jnp.float32)[:, idx]
    band_chunk = jnp.repeat(jnp.arange(BAND_CHUNKS), CHUNK)
    scale = HEAD_DIM ** -0.5

    def one_chunk(c):
        qc = lax.dynamic_index_in_dim(q, c, axis=1, keepdims=False)
        kb = lax.dynamic_slice_in_dim(kp, c, BAND_CHUNKS, axis=1).reshape(B, BAND, N_HEADS, HEAD_DIM)
        vb = lax.dynamic_slice_in_dim(vp, c, BAND_CHUNKS, axis=1).reshape(B, BAND, N_HEADS, HEAD_DIM)
        s = jnp.einsum('bqhd,bkhd->bhqk', qc, kb).astype(jnp.float32) * scale + bias[None]
        valid = (band_chunk + c - LEFT_CHUNKS) >= 0
        s = jnp.where(valid[None, None, None, :], s, -1e30)
        p = jax.nn.softmax(s, axis=-1).astype(vb.dtype)
        return jnp.einsum('bhqk,bkhd->bqhd', p, vb)

    o = lax.map(one_chunk, jnp.arange(nc))
    o = jnp.transpose(o, (1, 0, 2, 3, 4)).reshape(B, S, D)
    return o @ w_o


def conv_ffn(h, w_gate, w_val, conv_w, conv_b, w_out):
    S = h.shape[1]
    a = h @ w_gate
    ap = jnp.pad(a, ((0, 0), (CONV_W - 1, 0), (0, 0)))
    a = ap[:, 0:S] * conv_w[0] + ap[:, 1:S + 1] * conv_w[1] + ap[:, 2:S + 2] * conv_w[2] + conv_b
    return (jax.nn.silu(a) * (h @ w_val)) @ w_out


def setup_inputs(seed: int = 0) -> dict:
    key = jax.random.key(seed)
    ks = jax.random.split(key, 16)
    f32 = jnp.float32
    D, F = D_MODEL, D_FF
    nrm = lambda k, shape, s: jax.random.normal(k, shape, f32) * s
    return {
        "x": nrm(ks[0], (BATCH, SEQ, D), 1.0),
        "mix_norm": 1.0 + nrm(ks[1], (DEPTH, D), 0.02),
        "ffn_norm": 1.0 + nrm(ks[2], (DEPTH, D), 0.02),
        "pool_w": nrm(ks[3], (N_A, POOL_GROUPS, POOL_GW, POOL_GW), POOL_GW ** -0.5),
        "pool_b": nrm(ks[4], (N_A, D), 0.02),
        "pool_scale": 1.0 + nrm(ks[5], (N_A, D), 0.1),
        "attn_wqkv": nrm(ks[6], (N_B, D, 3 * D), D ** -0.5),
        "attn_q_norm": 1.0 + nrm(ks[7], (N_B, HEAD_DIM), 0.02),
        "attn_k_norm": 1.0 + nrm(ks[8], (N_B, HEAD_DIM), 0.02),
        "attn_rel_bias": nrm(ks[9], (N_B, N_HEADS, 2 * REL_CLIP + 1), 0.1),
        "attn_wo": nrm(ks[10], (N_B, D, D), D ** -0.5),
        "ffn_w_gate": nrm(ks[11], (DEPTH, D, F), D ** -0.5),
        "ffn_w_val": nrm(ks[12], (DEPTH, D, F), D ** -0.5),
        "ffn_conv_w": nrm(ks[13], (DEPTH, CONV_W, F), CONV_W ** -0.5),
        "ffn_conv_b": nrm(ks[14], (DEPTH, F), 0.02),
        "ffn_w_out": nrm(ks[15], (DEPTH, F, D), F ** -0.5),
    }


def reference(x, mix_norm, ffn_norm, pool_w, pool_b, pool_scale, attn_wqkv, attn_q_norm,
              attn_k_norm, attn_rel_bias, attn_wo, ffn_w_gate, ffn_w_val, ffn_conv_w,
              ffn_conv_b, ffn_w_out):
    for i in range(DEPTH):
        h = rmsnorm(x, mix_norm[i])
        j = i // N_MIXERS
        if i % N_MIXERS == 0:
            x = x + pool_mixer(h, pool_w[j], pool_b[j], pool_scale[j])
        else:
            x = x + chunk_attention(h, attn_wqkv[j], attn_q_norm[j], attn_k_norm[j],
                                    attn_rel_bias[j], attn_wo[j])
        h = rmsnorm(x, ffn_norm[i])
        x = x + conv_ffn(h, ffn_w_gate[i], ffn_w_val[i], ffn_conv_w[i], ffn_conv_b[i], ffn_w_out[i])
    return x
```

```cpp
#include <hip/hip_runtime.h>
#include <hip/hip_cooperative_groups.h>
#include <cstdio>
#include <cstdint>
namespace cg = cooperative_groups;

#define LAS __attribute__((address_space(3)))
typedef unsigned short bf16_t;
typedef short bf16x8 __attribute__((ext_vector_type(8)));
typedef short s16x4 __attribute__((ext_vector_type(4)));
typedef float f32x4 __attribute__((ext_vector_type(4)));
typedef float f32x2 __attribute__((ext_vector_type(2)));
typedef float f32x16 __attribute__((ext_vector_type(16)));
typedef unsigned u32x4 __attribute__((ext_vector_type(4)));
typedef unsigned u32x2 __attribute__((ext_vector_type(2)));
typedef _Float16 h2 __attribute__((ext_vector_type(2)));

constexpr int D = 1024, BATCH = 4, SEQ = 8192, DEPTH = 4, M = BATCH * SEQ, FF = 2816, NH = 16;
constexpr float EPS = 1e-6f;
constexpr float LOG2E = 1.4426950408889634f;

constexpr size_t MiB = 1u << 20;
constexpr size_t WS_POOLW = 0;
constexpr size_t WS_WQK   = 1 * MiB;
constexpr size_t WS_WVT   = 9 * MiB;
constexpr size_t WS_WO    = 13 * MiB;
constexpr size_t WS_WUP   = 17 * MiB;
constexpr size_t WS_WOUT  = 61 * MiB;
constexpr size_t WS_SSQ   = 83 * MiB;
constexpr size_t WS_XB    = 85 * MiB;
constexpr size_t WS_ACT   = 149 * MiB;
constexpr size_t WS_ABUF  = WS_ACT;
constexpr size_t WS_UBUF  = WS_ACT + 176 * MiB;
constexpr size_t WS_Q     = WS_ACT;
constexpr size_t WS_K     = WS_ACT + 64 * MiB;
constexpr size_t WS_VT    = WS_ACT + 128 * MiB;
constexpr size_t WS_O     = WS_ACT + 192 * MiB;
constexpr size_t WS_Y     = WS_ACT;
constexpr size_t WS_BOT   = WS_ACT;
constexpr size_t WS_TOPA  = WS_ACT + 3 * MiB;
constexpr size_t WS_TOPV  = WS_ACT + 6 * MiB;
constexpr size_t WS_CTL   = WS_ACT + 352 * MiB;
constexpr size_t CTL_BYTES = 65536;
constexpr size_t WS_END   = WS_CTL + CTL_BYTES;

constexpr int RING_BYTES = 131072;
constexpr int RS_OFF = RING_BYTES;
constexpr int XCH_OFF = RS_OFF + 11264;
constexpr int MISC_OFF = XCH_OFF + 4096;
constexpr int LDS_BYTES = 147456;

typedef __bf16 bf16x2_t __attribute__((ext_vector_type(2)));
__device__ __forceinline__ unsigned cvt_pk_bf16(float lo, float hi) { const f32x2 v = {lo, hi}; const bf16x2_t b = __builtin_convertvector(v, bf16x2_t); return __builtin_bit_cast(unsigned, b); }
__device__ __forceinline__ float bf_lo(unsigned w) { return __uint_as_float(w << 16); }
__device__ __forceinline__ float bf_hi(unsigned w) { return __uint_as_float(w & 0xffff0000u); }
__device__ __forceinline__ float wave_sum(float v) {
#pragma unroll
    for (int o = 1; o < 64; o <<= 1) v += __shfl_xor(v, o);
    return v;
}

namespace pg8 {
constexpr int BM = 256, BK = 64, HALF = 128, HTB = HALF * BK * 2, STAGE_BYTES = 8 * HTB, NXCD = 8, WGM = 8;
__host__ __device__ __forceinline__ int lds_byte(int r, int c) { const int st = (r >> 4) * 2 + (c >> 5), rr = r & 15, cc = c & 31, ob = rr * 64 + cc * 2; return st * 1024 + (ob ^ (((ob >> 9) & 1) << 5)); }
__host__ __device__ __forceinline__ void stage_rc(int b, int& R, int& C) { const int st = b / 1024, sb = b % 1024, swz = sb ^ (((sb >> 9) & 1) << 5); R = (st >> 1) * 16 + swz / 64; C = (st & 1) * 32 + (swz % 64) / 2; }
__host__ __device__ __forceinline__ int perm32(int rho) { const int n = rho >> 4, i = rho & 15; return 8 * (i >> 2) + 4 * n + (i & 3); }

struct Unit { int pm, pn; };
struct Gemm { const bf16_t* A; const bf16_t* Bt; int K, lda, ldb, a_pn_off; };

struct StaticOrder {
    int nM, nN, nwg, G, c;
    __host__ __device__ void init(int M_, int N_, int G_, int c_) { nM = M_ / BM; nN = N_ / BM; nwg = nM * nN; G = G_; c = c_; }
    __host__ __device__ bool next(int i, Unit& u) const {
        const long L = (long)i * G + c; if (L >= nwg) return false;
        int wgid = (int)L; { const int q = nwg / NXCD, r = nwg % NXCD, xcd = wgid % NXCD, off = wgid / NXCD; wgid = (xcd < r ? xcd * (q + 1) : r * (q + 1) + (xcd - r) * q) + off; }
        const int nig = WGM * nN, gid = wgid / nig, fm = gid * WGM, gsz = (nM - fm) < WGM ? (nM - fm) : WGM;
        u.pm = fm + ((wgid % nig) % gsz); u.pn = (wgid % nig) / gsz; return true;
    }
};

template <class Epi, class Sched>
__device__ __forceinline__ void gemm_phase(LAS unsigned char* lds, const Gemm g, const Sched& S, const Epi& E) {
    int tid = threadIdx.x; asm volatile("" : "+v"(tid));
    const int wid = __builtin_amdgcn_readfirstlane(tid >> 6), lane = tid & 63, wr = wid >> 2, wc = wid & 3, fr = lane & 15, fq = lane >> 4;
    const int nt = g.K / BK;
    unsigned voffA[2], voffB[2];
#pragma unroll
    for (int i = 0; i < 2; ++i) { int R, C; stage_rc(tid * 16 + i * 8192, R, C); const int Rb = Epi::PERM ? ((R & ~31) + perm32(R & 31)) : R;
        voffA[i] = (unsigned)(R * g.lda + C) * 2u; voffB[i] = (unsigned)(Rb * g.ldb + C) * 2u; }
    asm volatile("" : "+v"(voffA[0]), "+v"(voffA[1]), "+v"(voffB[0]), "+v"(voffB[1]));
    const size_t kstep = (size_t)(BK * 2);
    const size_t hstepA = (size_t)HALF * g.lda * 2, hstepB = (size_t)HALF * g.ldb * 2;
    const size_t tstepA = 2 * hstepA, tstepB = 2 * hstepB;
    const unsigned ldsw = (unsigned)wid * 1024u;
    const int aoff = lds_byte(wr * 64 + fr, fq * 8), boff = lds_byte(wc * 32 + fr, fq * 8);
#define PG8_SA(b, h) (((b) * 2 + (h)) * HTB)
#define PG8_SB(b, h) ((4 + (b) * 2 + (h)) * HTB)
#define PG8_STAGE(bufoff, gbase, voff) do { _Pragma("unroll") for (int _i = 0; _i < 2; ++_i) \
        __builtin_amdgcn_global_load_lds((const unsigned*)((const char*)(gbase) + (voff)[_i]), (LAS unsigned*)(lds + (bufoff) + ldsw + _i * 8192), 16, 0, 0); } while (0)
#define PG8_LDA(dst, b, h) do { _Pragma("unroll") for (int m = 0; m < 4; ++m) _Pragma("unroll") for (int k = 0; k < 2; ++k) dst[m][k] = *(const LAS bf16x8*)(lds + PG8_SA(b, h) + aoff + m * 2048 + k * 1024); } while (0)
#define PG8_LDB(dst, b, h) do { _Pragma("unroll") for (int n = 0; n < 2; ++n) _Pragma("unroll") for (int k = 0; k < 2; ++k) dst[n][k] = *(const LAS bf16x8*)(lds + PG8_SB(b, h) + boff + n * 2048 + k * 1024); } while (0)
#define PG8_MMA(ai, bj, At, Bt) do { __builtin_amdgcn_s_setprio(1); _Pragma("unroll") for (int m = 0; m < 4; ++m) _Pragma("unroll") for (int n = 0; n < 2; ++n) _Pragma("unroll") for (int k = 0; k < 2; ++k) \
        acc[ai][bj][m][n] = __builtin_amdgcn_mfma_f32_16x16x32_bf16(Bt[n][k], At[m][k], acc[ai][bj][m][n], 0, 0, 0); __builtin_amdgcn_s_setprio(0); } while (0)
#define PG8_WAIT_V(n) asm volatile("s_waitcnt vmcnt(" #n ")" ::: "memory")
#define PG8_WAIT_L(n) asm volatile("s_waitcnt lgkmcnt(" #n ")" ::: "memory")
#define PG8_BAR __builtin_amdgcn_s_barrier()
#define PG8_SCHED __builtin_amdgcn_sched_barrier(0)
    Unit cur, nxt; int ui = 0;
    if (!S.next(0, cur)) return;
    f32x4 acc[2][2][4][2];
    E.init(acc, cur, wr, wc, fr, fq);
    bf16x8 At[4][2], B0[2][2], B1[2][2];
    const char* cA = (const char*)g.A + (size_t)cur.pm * tstepA + (size_t)cur.pn * g.a_pn_off * 2; const char* cB = (const char*)g.Bt + (size_t)cur.pn * tstepB;
    PG8_STAGE(PG8_SB(0, 0), cB, voffB); PG8_STAGE(PG8_SB(0, 1), cB + hstepB, voffB); PG8_STAGE(PG8_SA(0, 0), cA, voffA); PG8_STAGE(PG8_SA(0, 1), cA + hstepA, voffA);
    if (wr == 1) PG8_BAR;
    PG8_WAIT_V(2); PG8_BAR;
    PG8_STAGE(PG8_SB(1, 0), cB + kstep, voffB); PG8_STAGE(PG8_SA(1, 0), cA + kstep, voffA); PG8_STAGE(PG8_SB(1, 1), cB + hstepB + kstep, voffB);
    PG8_WAIT_V(6); PG8_BAR;
    for (;;) {
        const bool has_next = S.next(ui + 1, nxt);
        const char* nA = has_next ? (const char*)g.A + (size_t)nxt.pm * tstepA + (size_t)nxt.pn * g.a_pn_off * 2 : cA; const char* nB = has_next ? (const char*)g.Bt + (size_t)nxt.pn * tstepB : cB;
        for (int t = 0; t < nt; t += 2) {
            const bool last = (t == nt - 2);
            const char* a1 = cA + (size_t)(t + 1) * kstep;
            const char* a2 = last ? nA : cA + (size_t)(t + 2) * kstep; const char* b2 = last ? nB : cB + (size_t)(t + 2) * kstep;
            const char* a3 = a2 + kstep; const char* b3 = b2 + kstep;
            PG8_LDB(B0, 0, 0); PG8_LDB(B1, 0, 1); PG8_SCHED; PG8_LDA(At, 0, 0); PG8_STAGE(PG8_SA(1, 1), a1 + hstepA, voffA);
            PG8_WAIT_V(8); PG8_WAIT_L(0); PG8_BAR; PG8_MMA(0, 0, At, B0); PG8_MMA(0, 1, At, B1); PG8_BAR; PG8_SCHED;
            PG8_LDA(At, 0, 1); PG8_STAGE(PG8_SB(0, 0), b2, voffB); PG8_STAGE(PG8_SB(0, 1), b2 + hstepB, voffB); PG8_STAGE(PG8_SA(0, 0), a2, voffA);
            PG8_WAIT_V(8); PG8_WAIT_L(0); PG8_BAR; PG8_MMA(1, 0, At, B0); PG8_MMA(1, 1, At, B1); PG8_BAR; PG8_SCHED;
            PG8_LDB(B0, 1, 0); PG8_LDB(B1, 1, 1); PG8_SCHED; PG8_LDA(At, 1, 0); PG8_STAGE(PG8_SA(0, 1), a2 + hstepA, voffA);
            PG8_WAIT_V(8); PG8_WAIT_L(0); PG8_BAR; PG8_MMA(0, 0, At, B0); PG8_MMA(0, 1, At, B1); PG8_BAR; PG8_SCHED;
            PG8_LDA(At, 1, 1); PG8_STAGE(PG8_SB(1, 0), b3, voffB); PG8_STAGE(PG8_SB(1, 1), b3 + hstepB, voffB); PG8_STAGE(PG8_SA(1, 0), a3, voffA);
            PG8_WAIT_V(8); PG8_WAIT_L(0); PG8_BAR; PG8_MMA(1, 0, At, B0); PG8_MMA(1, 1, At, B1); PG8_BAR; PG8_SCHED;
        }
        if (wr == 0) PG8_BAR;
        E(acc, cur, ui, wr, wc, fr, fq);
        if (!has_next) break;
        E.init(acc, nxt, wr, wc, fr, fq);
        cur = nxt; cA = nA; cB = nB; ++ui;
        if (wr == 1) PG8_BAR;
    }
    PG8_WAIT_V(0);
    PG8_BAR;
#undef PG8_SA
#undef PG8_SB
#undef PG8_STAGE
#undef PG8_LDA
#undef PG8_LDB
#undef PG8_MMA
#undef PG8_WAIT_V
#undef PG8_WAIT_L
#undef PG8_BAR
#undef PG8_SCHED
}
}

__device__ __forceinline__ void acc_zero(f32x4 (&acc)[2][2][4][2]) {
#pragma unroll
    for (int a = 0; a < 2; ++a)
#pragma unroll
        for (int b = 0; b < 2; ++b)
#pragma unroll
            for (int m = 0; m < 4; ++m)
#pragma unroll
                for (int n = 0; n < 2; ++n) acc[a][b][m][n] = (f32x4){0.f, 0.f, 0.f, 0.f};
}
template <bool AFFINE, bool BASE_F32, bool OUT_F32> struct EpiRes {
    static constexpr bool PERM = true;
    const float* base32; float* out32; bf16_t* xb; float* ssqp; const float* bias; const float* scale;
    __device__ __forceinline__ void init(f32x4 (&acc)[2][2][4][2], const pg8::Unit& u, int wr, int wc, int fr, int fq) const {
        const int col0 = u.pn * 256 + wc * 32 + 8 * fq;
        const size_t off0 = (size_t)(u.pm * 256 + wr * 64 + fr) * D + col0;
#pragma unroll
        for (int ai = 0; ai < 2; ++ai)
#pragma unroll
            for (int m = 0; m < 4; ++m)
#pragma unroll
                for (int bj = 0; bj < 2; ++bj) {
                    const size_t off = off0 + (size_t)(ai * 128 + m * 16) * D + bj * 128;
                    if (BASE_F32) { acc[ai][bj][m][0] = *(const f32x4*)(base32 + off); acc[ai][bj][m][1] = *(const f32x4*)(base32 + off + 4); }
                    else { const u32x4 w = *(const u32x4*)(xb + off);
                        acc[ai][bj][m][0] = (f32x4){bf_lo(w.x), bf_hi(w.x), bf_lo(w.y), bf_hi(w.y)}; acc[ai][bj][m][1] = (f32x4){bf_lo(w.z), bf_hi(w.z), bf_lo(w.w), bf_hi(w.w)}; }
                }
        if (AFFINE) {
#pragma unroll
            for (int bj = 0; bj < 2; ++bj)
#pragma unroll
                for (int n = 0; n < 2; ++n) { const f32x4 bs = *(const f32x4*)(bias + col0 + bj * 128 + 4 * n) * *(const f32x4*)(scale + col0 + bj * 128 + 4 * n);
#pragma unroll
                    for (int ai = 0; ai < 2; ++ai)
#pragma unroll
                        for (int m = 0; m < 4; ++m) acc[ai][bj][m][n] += bs; }
        }
    }
    __device__ __forceinline__ void operator()(const f32x4 (&acc)[2][2][4][2], const pg8::Unit& u, int ui, int wr, int wc, int fr, int fq) const {
        const int col0 = u.pn * 256 + wc * 32 + 8 * fq;
#pragma unroll
        for (int ai = 0; ai < 2; ++ai)
#pragma unroll
            for (int m = 0; m < 4; ++m) {
                const int row = u.pm * 256 + ai * 128 + wr * 64 + m * 16 + fr;
                float ss = 0.f;
#pragma unroll
                for (int bj = 0; bj < 2; ++bj) {
                    const size_t off = (size_t)row * D + col0 + bj * 128;
                    const f32x4 o0 = acc[ai][bj][m][0], o1 = acc[ai][bj][m][1];
                    if (OUT_F32) { *(f32x4*)(out32 + off) = o0; *(f32x4*)(out32 + off + 4) = o1; }
                    else {
                        ss += (o0[0] * o0[0] + o0[1] * o0[1]) + (o0[2] * o0[2] + o0[3] * o0[3]) + (o1[0] * o1[0] + o1[1] * o1[1]) + (o1[2] * o1[2] + o1[3] * o1[3]);
                        u32x4 w; w.x = cvt_pk_bf16(o0[0], o0[1]); w.y = cvt_pk_bf16(o0[2], o0[3]); w.z = cvt_pk_bf16(o1[0], o1[1]); w.w = cvt_pk_bf16(o1[2], o1[3]);
                        *(u32x4*)(xb + off) = w; }
                }
                if (!OUT_F32) { ss += __shfl_xor(ss, 16); ss += __shfl_xor(ss, 32);
                    if (fq == 0) ssqp[(size_t)row * 16 + u.pn * 4 + wc] = ss; }
            }
    }
};

struct EpiQK {
    static constexpr bool PERM = true;
    __device__ __forceinline__ void init(f32x4 (&acc)[2][2][4][2], const pg8::Unit&, int, int, int, int) const { acc_zero(acc); }
    bf16_t* Q; bf16_t* Kb; const float* qn; const float* kn; const LAS float* rs;
    __device__ __forceinline__ void operator()(const f32x4 (&acc)[2][2][4][2], const pg8::Unit& u, int ui, int wr, int wc, int fr, int fq) const {
        const bool isq = u.pn < 4; bf16_t* dst = isq ? Q : Kb; const float* nw = isq ? qn : kn; const float sc = isq ? 0.125f * LOG2E : 1.f;
        const int head = (u.pn & 3) * 4 + wc;
        f32x4 w[2][2];
#pragma unroll
        for (int bj = 0; bj < 2; ++bj)
#pragma unroll
            for (int n = 0; n < 2; ++n) w[bj][n] = *(const f32x4*)(nw + 32 * bj + 8 * fq + 4 * n) * sc;
#pragma unroll
        for (int ai = 0; ai < 2; ++ai)
#pragma unroll
            for (int m = 0; m < 4; ++m) {
                const int rl = ai * 128 + wr * 64 + m * 16 + fr;
                const float r = rs[ui * 256 + rl];
                f32x4 v[2][2]; float ss = 0.f;
#pragma unroll
                for (int bj = 0; bj < 2; ++bj)
#pragma unroll
                    for (int n = 0; n < 2; ++n) { v[bj][n] = acc[ai][bj][m][n] * r; const f32x4 x = v[bj][n]; ss += (x[0] * x[0] + x[1] * x[1]) + (x[2] * x[2] + x[3] * x[3]); }
                ss += __shfl_xor(ss, 16); ss += __shfl_xor(ss, 32);
                const float inv = rsqrtf(ss * (1.f / 64.f) + EPS);
#pragma unroll
                for (int bj = 0; bj < 2; ++bj) {
                    const f32x4 o0 = v[bj][0] * inv * w[bj][0], o1 = v[bj][1] * inv * w[bj][1];
                    u32x4 pk; pk.x = cvt_pk_bf16(o0[0], o0[1]); pk.y = cvt_pk_bf16(o0[2], o0[3]); pk.z = cvt_pk_bf16(o1[0], o1[1]); pk.w = cvt_pk_bf16(o1[2], o1[3]);
                    *(u32x4*)(dst + (size_t)(u.pm * 256 + rl) * D + head * 64 + 32 * bj + 8 * fq) = pk;
                }
            }
    }
};

struct EpiVt {
    static constexpr bool PERM = true;
    __device__ __forceinline__ void init(f32x4 (&acc)[2][2][4][2], const pg8::Unit&, int, int, int, int) const { acc_zero(acc); }
    bf16_t* Vt; const LAS float* rs;
    __device__ __forceinline__ void operator()(const f32x4 (&acc)[2][2][4][2], const pg8::Unit& u, int ui, int wr, int wc, int fr, int fq) const {
        f32x4 r[2][2];
#pragma unroll
        for (int bj = 0; bj < 2; ++bj)
#pragma unroll
            for (int n = 0; n < 2; ++n) r[bj][n] = *(const LAS f32x4*)(rs + ui * 256 + bj * 128 + wc * 32 + 8 * fq + 4 * n);
#pragma unroll
        for (int ai = 0; ai < 2; ++ai)
#pragma unroll
            for (int m = 0; m < 4; ++m) {
                const int hd = u.pm * 256 + ai * 128 + wr * 64 + m * 16 + fr;
#pragma unroll
                for (int bj = 0; bj < 2; ++bj) {
                    const f32x4 o0 = acc[ai][bj][m][0] * r[bj][0], o1 = acc[ai][bj][m][1] * r[bj][1];
                    u32x4 pk; pk.x = cvt_pk_bf16(o0[0], o0[1]); pk.y = cvt_pk_bf16(o0[2], o0[3]); pk.z = cvt_pk_bf16(o1[0], o1[1]); pk.w = cvt_pk_bf16(o1[2], o1[3]);
                    *(u32x4*)(Vt + (size_t)hd * M + u.pn * 256 + bj * 128 + wc * 32 + 8 * fq) = pk;
                }
            }
    }
};

struct EpiUp {
    static constexpr bool PERM = true;
    __device__ __forceinline__ void init(f32x4 (&acc)[2][2][4][2], const pg8::Unit&, int, int, int, int) const { acc_zero(acc); }
    bf16_t* Ab; bf16_t* Vb; const LAS float* rs;
    __device__ __forceinline__ void operator()(const f32x4 (&acc)[2][2][4][2], const pg8::Unit& u, int ui, int wr, int wc, int fr, int fq) const {
#pragma unroll
        for (int ai = 0; ai < 2; ++ai)
#pragma unroll
            for (int m = 0; m < 4; ++m) {
                const int rl = ai * 128 + wr * 64 + m * 16 + fr;
                const float r = rs[ui * 256 + rl];
                const size_t off = (size_t)(u.pm * 256 + rl) * FF + u.pn * 128 + wc * 32 + 8 * fq;
#pragma unroll
                for (int bj = 0; bj < 2; ++bj) {
                    const f32x4 o0 = acc[ai][bj][m][0] * r, o1 = acc[ai][bj][m][1] * r;
                    u32x4 pk; pk.x = cvt_pk_bf16(o0[0], o0[1]); pk.y = cvt_pk_bf16(o0[2], o0[3]); pk.z = cvt_pk_bf16(o1[0], o1[1]); pk.w = cvt_pk_bf16(o1[2], o1[3]);
                    *(u32x4*)((bj == 0 ? Ab : Vb) + off) = pk;
                }
            }
    }
};

__device__ __forceinline__ float dpp_ror1(float v) { return __int_as_float(__builtin_amdgcn_mov_dpp(__float_as_int(v), 0x121, 0xf, 0xf, true)); }
__device__ __forceinline__ float dpp_ror2(float v) { return __int_as_float(__builtin_amdgcn_mov_dpp(__float_as_int(v), 0x122, 0xf, 0xf, true)); }
__device__ __forceinline__ float dpp_shr1(float old, float v) { return __int_as_float(__builtin_amdgcn_update_dpp(__float_as_int(old), __float_as_int(v), 0x111, 0xf, 0xf, false)); }
__device__ __forceinline__ float dpp_shr2(float old, float v) { return __int_as_float(__builtin_amdgcn_update_dpp(__float_as_int(old), __float_as_int(v), 0x112, 0xf, 0xf, false)); }
__device__ __forceinline__ float silu_f(float c) { return c * __builtin_amdgcn_rcpf(1.f + __builtin_amdgcn_exp2f(-c * LOG2E)); }
struct EpiUpConv {
    static constexpr bool PERM = true;
    __device__ __forceinline__ void init(f32x4 (&acc)[2][2][4][2], const pg8::Unit&, int, int, int, int) const { acc_zero(acc); }
    bf16_t* U; const LAS float* rs; LAS float* xch; const float* cw; const float* cb; float* bot; float* topa; float* topv;
    __device__ __forceinline__ void operator()(const f32x4 (&acc)[2][2][4][2], const pg8::Unit& u, int ui, int wr, int wc, int fr, int fq) const {
        const int fcol = u.pn * 128 + wc * 32 + 8 * fq;
        f32x4 w0[2], w1[2], w2[2], bb[2];
#pragma unroll
        for (int n = 0; n < 2; ++n) { w0[n] = *(const f32x4*)(cw + fcol + 4 * n); w1[n] = *(const f32x4*)(cw + FF + fcol + 4 * n); w2[n] = *(const f32x4*)(cw + 2 * FF + fcol + 4 * n); bb[n] = *(const f32x4*)(cb + fcol + 4 * n); }
        h2 w0h[2][2], w1h[2][2], w2h[2][2], bbh[2][2];
#pragma unroll
        for (int n = 0; n < 2; ++n)
#pragma unroll
            for (int q = 0; q < 2; ++q) { w0h[n][q] = (h2){(_Float16)w0[n][2 * q], (_Float16)w0[n][2 * q + 1]}; w1h[n][q] = (h2){(_Float16)w1[n][2 * q], (_Float16)w1[n][2 * q + 1]};
                w2h[n][q] = (h2){(_Float16)w2[n][2 * q], (_Float16)w2[n][2 * q + 1]}; bbh[n][q] = (h2){(_Float16)bb[n][2 * q], (_Float16)bb[n][2 * q + 1]}; }
        float rr[2][4];
#pragma unroll
        for (int ai = 0; ai < 2; ++ai)
#pragma unroll
            for (int m = 0; m < 4; ++m) rr[ai][m] = rs[ui * 256 + ai * 128 + wr * 64 + m * 16 + fr];
        if (fr >= 14) {
#pragma unroll
            for (int ai = 0; ai < 2; ++ai)
#pragma unroll
                for (int n = 0; n < 2; ++n) *(LAS f32x4*)(xch + ((ai * 2 + wr) * 4 + wc) * 64 + (fr - 14) * 32 + 8 * fq + 4 * n) = acc[ai][0][3][n] * rr[ai][3];
        }
        asm volatile("s_waitcnt lgkmcnt(0)" ::: "memory"); __builtin_amdgcn_s_barrier(); asm volatile("" ::: "memory");
#pragma unroll
        for (int ai = 0; ai < 2; ++ai) {
            f32x4 pv[2];
            if (ai == 0 && wr == 0) { pv[0] = (f32x4){0.f, 0.f, 0.f, 0.f}; pv[1] = pv[0]; }
            else { const int pai = (wr == 1) ? ai : ai - 1, pwr = wr ^ 1; const int xr = (fr >= 14) ? fr - 14 : 0;
#pragma unroll
                for (int n = 0; n < 2; ++n) pv[n] = *(const LAS f32x4*)(xch + ((pai * 2 + pwr) * 4 + wc) * 64 + xr * 32 + 8 * fq + 4 * n); }
            int t1p[2][2], t2p[2][2];
#pragma unroll
            for (int n = 0; n < 2; ++n)
#pragma unroll
                for (int q = 0; q < 2; ++q) { const int pb = __builtin_bit_cast(int, __builtin_amdgcn_cvt_pkrtz(pv[n][2 * q], pv[n][2 * q + 1]));
                    t1p[n][q] = __builtin_amdgcn_mov_dpp(pb, 0x121, 0xf, 0xf, true); t2p[n][q] = __builtin_amdgcn_mov_dpp(pb, 0x122, 0xf, 0xf, true); }
#pragma unroll
            for (int m = 0; m < 4; ++m) {
                const int rl = ai * 128 + wr * 64 + m * 16 + fr;
                f32x4 a[2], o[2];
#pragma unroll
                for (int n = 0; n < 2; ++n) {
                    a[n] = acc[ai][0][m][n] * rr[ai][m];
                    const f32x4 v = acc[ai][1][m][n] * rr[ai][m];
#pragma unroll
                    for (int q = 0; q < 2; ++q) {
                        const int xb = __builtin_bit_cast(int, __builtin_amdgcn_cvt_pkrtz(a[n][2 * q], a[n][2 * q + 1]));
                        const int t1 = __builtin_amdgcn_mov_dpp(xb, 0x121, 0xf, 0xf, true), t2 = __builtin_amdgcn_mov_dpp(xb, 0x122, 0xf, 0xf, true);
                        const h2 p1 = __builtin_bit_cast(h2, (fr == 0) ? t1p[n][q] : t1), p2 = __builtin_bit_cast(h2, (fr < 2) ? t2p[n][q] : t2), x2 = __builtin_bit_cast(h2, xb);
                        t1p[n][q] = t1; t2p[n][q] = t2;
                        const h2 c = p2 * w0h[n][q] + (p1 * w1h[n][q] + (x2 * w2h[n][q] + bbh[n][q]));
                        const h2 ea = c * (h2){(_Float16)(-LOG2E), (_Float16)(-LOG2E)};
                        h2 ex; ex.x = __builtin_exp2f16(ea.x); ex.y = __builtin_exp2f16(ea.y);
                        const h2 dn = ex + (h2){(_Float16)1.f, (_Float16)1.f};
                        h2 rc; rc.x = __builtin_amdgcn_rcph(dn.x); rc.y = __builtin_amdgcn_rcph(dn.y);
                        const h2 sg = c * rc;
                        o[n][2 * q] = (float)sg.x * v[2 * q]; o[n][2 * q + 1] = (float)sg.y * v[2 * q + 1];
                    }
                }
                u32x4 pk; pk.x = cvt_pk_bf16(o[0][0], o[0][1]); pk.y = cvt_pk_bf16(o[0][2], o[0][3]); pk.z = cvt_pk_bf16(o[1][0], o[1][1]); pk.w = cvt_pk_bf16(o[1][2], o[1][3]);
                *(u32x4*)(U + (size_t)(u.pm * 256 + rl) * FF + fcol) = pk;
                if (ai == 0 && m == 0 && wr == 0 && fr < 2) {
#pragma unroll
                    for (int n = 0; n < 2; ++n) { *(f32x4*)(topa + (size_t)(u.pm * 2 + fr) * FF + fcol + 4 * n) = a[n]; *(f32x4*)(topv + (size_t)(u.pm * 2 + fr) * FF + fcol + 4 * n) = acc[0][1][0][n] * rr[0][0]; }
                }
                if (ai == 1 && m == 3 && wr == 1 && fr >= 14) {
#pragma unroll
                    for (int n = 0; n < 2; ++n) *(f32x4*)(bot + (size_t)(u.pm * 2 + fr - 14) * FF + fcol + 4 * n) = a[n];
                }
            }
        }
    }
};
template <class Sched> __device__ __forceinline__ void conv_fixup(const Sched& S, bf16_t* U, const float* bot, const float* topa, const float* topv, const float* cw, const float* cb) {
    pg8::Unit u; int tid = threadIdx.x; asm volatile("" : "+v"(tid));
    constexpr int NIT = (FF + 511) / 512;
    for (int i = 0; S.next(i, u); ++i) {
        if ((u.pm & 31) == 0) continue;
        float v[NIT][10];
#pragma unroll
        for (int k = 0; k < NIT; ++k) {
            const int f = min(tid + 512 * k, FF - 1);
            v[k][0] = bot[(size_t)((u.pm - 1) * 2) * FF + f]; v[k][1] = bot[(size_t)((u.pm - 1) * 2 + 1) * FF + f];
            v[k][2] = topa[(size_t)(u.pm * 2) * FF + f]; v[k][3] = topa[(size_t)(u.pm * 2 + 1) * FF + f];
            v[k][4] = topv[(size_t)(u.pm * 2) * FF + f]; v[k][5] = topv[(size_t)(u.pm * 2 + 1) * FF + f];
            v[k][6] = cw[f]; v[k][7] = cw[FF + f]; v[k][8] = cw[2 * FF + f]; v[k][9] = cb[f];
        }
#pragma unroll
        for (int k = 0; k < NIT; ++k) {
            const int f = tid + 512 * k;
            const float c0 = v[k][0] * v[k][6] + v[k][1] * v[k][7] + v[k][2] * v[k][8] + v[k][9], c1 = v[k][1] * v[k][6] + v[k][2] * v[k][7] + v[k][3] * v[k][8] + v[k][9];
            const unsigned r0 = cvt_pk_bf16(silu_f(c0) * v[k][4], 0.f), r1 = cvt_pk_bf16(silu_f(c1) * v[k][5], 0.f);
            if (f < FF) { U[(size_t)(u.pm * 256) * FF + f] = (bf16_t)(r0 & 0xffffu); U[(size_t)(u.pm * 256 + 1) * FF + f] = (bf16_t)(r1 & 0xffffu); }
        }
    }
    asm volatile("s_waitcnt vmcnt(0)" ::: "memory");
    __syncthreads();
}

template <int MAXU, class Sched> __device__ __forceinline__ void fill_rstd(LAS float* rs, const float* ssqp, const Sched& S, bool by_pn) {
    pg8::Unit u0; int tid = threadIdx.x; asm volatile("" : "+v"(tid));
    if (S.next(0, u0)) {
        f32x4 a[MAXU], b[MAXU]; bool have[MAXU];
#pragma unroll
        for (int i = 0; i < MAXU; ++i) {
            pg8::Unit u; have[i] = S.next(i, u); if (!have[i]) u = u0;
            const int row = 256 * (by_pn ? u.pn : u.pm) + (tid >> 1);
            const f32x4* p = (const f32x4*)(ssqp + (size_t)row * 16 + (tid & 1) * 8);
            a[i] = p[0]; b[i] = p[1];
        }
#pragma unroll
        for (int i = 0; i < MAXU; ++i) {
            float s = (a[i][0] + a[i][1]) + (a[i][2] + a[i][3]) + (b[i][0] + b[i][1]) + (b[i][2] + b[i][3]);
            s += __shfl_xor(s, 1);
            if (have[i] && !(tid & 1)) rs[i * 256 + (tid >> 1)] = rsqrtf(s * (1.f / D) + EPS);
        }
    }
    __syncthreads();
}

__device__ __forceinline__ void transpose_item(const float* W, int ldn, int k0, int n0, const float* gk, bf16_t* WT, int ldk, int drow0, LAS float* scr, int lane, const float* gn = nullptr) {
    const float gnv = gn ? gn[lane & 31] : 1.f;
    float wv[32];
#pragma unroll
    for (int i = 0; i < 32; ++i) wv[i] = W[(size_t)(k0 + 2 * i + (lane >> 5)) * ldn + n0 + (lane & 31)];
#pragma unroll
    for (int i = 0; i < 32; ++i) { const int kk = 2 * i + (lane >> 5); float v = wv[i] * gnv; if (gk) v *= gk[k0 + kk]; scr[kk * 33 + (lane & 31)] = v; }
    asm volatile("s_waitcnt lgkmcnt(0)" ::: "memory");
    const int c = lane & 7;
#pragma unroll
    for (int j = 0; j < 4; ++j) { const int n = (lane >> 3) + 8 * j; const LAS float* s = scr + (8 * c) * 33 + n;
        u32x4 o; o.x = cvt_pk_bf16(s[0 * 33], s[1 * 33]); o.y = cvt_pk_bf16(s[2 * 33], s[3 * 33]); o.z = cvt_pk_bf16(s[4 * 33], s[5 * 33]); o.w = cvt_pk_bf16(s[6 * 33], s[7 * 33]);
        *(u32x4*)(WT + (size_t)(drow0 + n) * ldk + k0 + 8 * c) = o; }
    asm volatile("s_waitcnt lgkmcnt(0)" ::: "memory");
}

struct Params {
    const float* x; const float* mix_norm; const float* ffn_norm; const float* pool_w; const float* pool_b; const float* pool_scale;
    const float* wqkv; const float* q_norm; const float* k_norm; const float* rel_bias; const float* wo;
    const float* w_gate; const float* w_val; const float* conv_w; const float* conv_b; const float* w_out;
    float* out; unsigned char* ws;
};

__device__ __forceinline__ void convert_weights(const Params& p, LAS unsigned char* lds, int gw, int NGW, int wave, int lane) {
    LAS float* scr = (LAS float*)(lds + wave * 16384);
    constexpr int I_POOL = 2 * 4 * (4 * 8);
    constexpr int I_QKV = 2 * (16 * 96);
    constexpr int I_WO = 2 * (16 * 32);
    constexpr int I_UP = 4 * 2 * (16 * 88);
    constexpr int I_OUT = 4 * (44 * 32);
    constexpr int NITEMS = I_POOL + I_QKV + I_WO + I_UP + I_OUT;
    for (int it = gw; it < NITEMS; it += NGW) {
        int r = it;
        if (r < I_POOL) {
            const int jg = r / 32, q = r % 32, kb = q / 8, nb = q % 8;
            transpose_item(p.pool_w + (size_t)jg * 65536, 256, 64 * kb, 32 * nb, nullptr, (bf16_t*)(p.ws + WS_POOLW) + (size_t)(jg >> 2) * 1024 * 256, 256, (jg & 3) * 256 + 32 * nb, scr, lane, p.pool_scale + (size_t)(jg >> 2) * D + (jg & 3) * 256 + 32 * nb);
            continue; }
        r -= I_POOL;
        if (r < I_QKV) {
            const int j = r / 1536, q = r % 1536, kb = q / 96, nb = q % 96, n0 = 32 * nb;
            const float* W = p.wqkv + (size_t)j * D * 3 * D; const float* gk = p.mix_norm + (size_t)(2 * j + 1) * D;
            if (n0 < 2048) { const int pn = n0 >> 8, nl = n0 & 255, wc = nl >> 6, dd = nl & 63, bj = dd >> 5;
                transpose_item(W, 3 * D, 64 * kb, n0, gk, (bf16_t*)(p.ws + WS_WQK) + (size_t)j * 2048 * D, D, 256 * pn + 128 * bj + 32 * wc, scr, lane); }
            else transpose_item(W, 3 * D, 64 * kb, n0, gk, (bf16_t*)(p.ws + WS_WVT) + (size_t)j * D * D, D, n0 - 2048, scr, lane);
            continue; }
        r -= I_QKV;
        if (r < I_WO) {
            const int j = r / 512, q = r % 512, kb = q / 32, nb = q % 32;
            transpose_item(p.wo + (size_t)j * D * D, D, 64 * kb, 32 * nb, nullptr, (bf16_t*)(p.ws + WS_WO) + (size_t)j * D * D, D, 32 * nb, scr, lane);
            continue; }
        r -= I_WO;
        if (r < I_UP) {
            const int i = r / 2816, q = r % 2816, isval = q / 1408, q2 = q % 1408, kb = q2 / 88, nb = q2 % 88, f0 = 32 * nb;
            const float* W = (isval ? p.w_val : p.w_gate) + (size_t)i * D * FF;
            transpose_item(W, FF, 64 * kb, f0, p.ffn_norm + (size_t)i * D, (bf16_t*)(p.ws + WS_WUP) + (size_t)i * 5632 * D, D, 256 * (f0 >> 7) + 128 * isval + (f0 & 127), scr, lane);
            continue; }
        r -= I_UP;
        {
            const int i = r / 1408, q = r % 1408, kb = q / 32, nb = q % 32;
            transpose_item(p.w_out + (size_t)i * FF * D, D, 64 * kb, 32 * nb, nullptr, (bf16_t*)(p.ws + WS_WOUT) + (size_t)i * D * FF, FF, 32 * nb, scr, lane);
        }
    }
}

template <bool IN_BF16> __device__ __forceinline__ void pool_prep(const void* xin_, const float* g, bf16_t* Y, LAS unsigned char* lds, int vcu, int G) {
    const float* xin = (const float*)xin_; const bf16_t* xinb = (const bf16_t*)xin_;
    LAS float* hs = (LAS float*)lds;
    int tid = threadIdx.x; asm volatile("" : "+v"(tid));
    const int lane = tid & 63, wave = tid >> 6;
    constexpr int RUN = 128;
    for (int run = vcu; run < M / RUN; run += G) {
        for (int k = 0; k < RUN / 16; ++k) {
            const int T0 = run * RUN + k * 16, ts0 = T0 & (SEQ - 1);
            const int nrow = (k == 0) ? 31 : 16, rbase = (k == 0) ? T0 - 15 : T0;
            {
                f32x4 v[4][4];
#pragma unroll
                for (int q = 0; q < 4; ++q) {
                    const int i = wave + 8 * q; const bool ok = (i < nrow) && (((rbase + i) & (SEQ - 1)) <= ts0 + 15) ;
                    const size_t rowo = (size_t)((i < nrow && rbase + i >= 0 && !(ts0 == 0 && k == 0 && i < 15)) ? rbase + i : T0) * D;
                    if (q < 2 || k == 0) {
                        if (IN_BF16) { const u32x2* xr = (const u32x2*)(xinb + rowo) + lane;
#pragma unroll
                            for (int j = 0; j < 4; ++j) { const u32x2 wv = xr[64 * j]; v[q][j] = (f32x4){bf_lo(wv.x), bf_hi(wv.x), bf_lo(wv.y), bf_hi(wv.y)}; } }
                        else { const f32x4* xr = (const f32x4*)(xin + rowo) + lane;
#pragma unroll
                            for (int j = 0; j < 4; ++j) v[q][j] = xr[64 * j]; }
                    }
                    (void)ok;
                }
#pragma unroll
                for (int q = 0; q < 4; ++q) {
                    const int i = wave + 8 * q;
                    if (i < nrow && (q < 2 || k == 0)) {
                        const int row = rbase + i;
                        LAS f32x4* hrow = (LAS f32x4*)(hs + (row & 31) * 1024) + lane;
                        float s = 0.f;
#pragma unroll
                        for (int j = 0; j < 4; ++j) s += (v[q][j][0] * v[q][j][0] + v[q][j][1] * v[q][j][1]) + (v[q][j][2] * v[q][j][2] + v[q][j][3] * v[q][j][3]);
                        float rstd = rsqrtf(wave_sum(s) * (1.f / D) + EPS);
                        if (ts0 == 0 && k == 0 && i < 15) rstd = 0.f;
#pragma unroll
                        for (int j = 0; j < 4; ++j) { const f32x4 gg = *((const f32x4*)g + lane + 64 * j); hrow[64 * j] = v[q][j] * rstd * gg; }
                    }
                }
            }
            __syncthreads();
            {
                const int c = 2 * tid, grp = c >> 8, w = 2 << grp;
                const LAS f32x2* hc = (const LAS f32x2*)(hs + c);
                f32x2 s = (f32x2){0.f, 0.f};
                for (int kk = 1; kk < w; ++kk) s += hc[((T0 - kk) & 31) * 512];
#pragma unroll 4
                for (int r = 0; r < 16; ++r) {
                    const f32x2 hv = hc[((T0 + r) & 31) * 512];
                    s += hv;
                    const int cnt = min(ts0 + r + 1, w);
                    const float ic = 1.f / (float)cnt;
                    const f32x2 y = s * ic - hv;
                    *(unsigned*)(Y + (size_t)(T0 + r) * D + c) = cvt_pk_bf16(y[0], y[1]);
                    s -= hc[((T0 + r - (w - 1)) & 31) * 512];
                }
            }
            __syncthreads();
        }
    }
}

__device__ __forceinline__ void conv_phase(const bf16_t* Ab, bf16_t* UV, const float* cw, const float* cb, int gthread, int nthreads) {
    constexpr int VC = FF / 8, NRUN = (M / 16) * VC;
    for (int run = gthread; run < NRUN; run += nthreads) {
        const int rb = run / VC, vc = run % VC, R0 = rb * 16, f0 = vc * 8;
        float w0[8], w1[8], w2[8], bb[8];
#pragma unroll
        for (int h = 0; h < 2; ++h) {
            const f32x4 a = *(const f32x4*)(cw + f0 + 4 * h), b = *(const f32x4*)(cw + FF + f0 + 4 * h), c = *(const f32x4*)(cw + 2 * FF + f0 + 4 * h), d = *(const f32x4*)(cb + f0 + 4 * h);
#pragma unroll
            for (int e = 0; e < 4; ++e) { w0[4 * h + e] = a[e]; w1[4 * h + e] = b[e]; w2[4 * h + e] = c[e]; bb[4 * h + e] = d[e]; }
        }
        float am2[8], am1[8];
        if ((R0 & (SEQ - 1)) == 0) {
#pragma unroll
            for (int e = 0; e < 8; ++e) { am2[e] = 0.f; am1[e] = 0.f; }
        } else {
            const u32x4 p2 = *(const u32x4*)(Ab + (size_t)(R0 - 2) * FF + f0), p1 = *(const u32x4*)(Ab + (size_t)(R0 - 1) * FF + f0);
#pragma unroll
            for (int e = 0; e < 4; ++e) { am2[2 * e] = bf_lo(p2[e]); am2[2 * e + 1] = bf_hi(p2[e]); am1[2 * e] = bf_lo(p1[e]); am1[2 * e + 1] = bf_hi(p1[e]); }
        }
#pragma unroll 4
        for (int r = 0; r < 16; ++r) {
            const size_t off = (size_t)(R0 + r) * FF + f0;
            const u32x4 pa = *(const u32x4*)(Ab + off), pv = *(const u32x4*)(UV + off);
            float a0[8], vv[8], o[8];
#pragma unroll
            for (int e = 0; e < 4; ++e) { a0[2 * e] = bf_lo(pa[e]); a0[2 * e + 1] = bf_hi(pa[e]); vv[2 * e] = bf_lo(pv[e]); vv[2 * e + 1] = bf_hi(pv[e]); }
#pragma unroll
            for (int e = 0; e < 8; ++e) {
                const float c = am2[e] * w0[e] + am1[e] * w1[e] + a0[e] * w2[e] + bb[e];
                const float sg = __builtin_amdgcn_rcpf(1.f + __builtin_amdgcn_exp2f(-c * LOG2E));
                o[e] = c * sg * vv[e];
                am2[e] = am1[e]; am1[e] = a0[e];
            }
            u32x4 pk; pk.x = cvt_pk_bf16(o[0], o[1]); pk.y = cvt_pk_bf16(o[2], o[3]); pk.z = cvt_pk_bf16(o[4], o[5]); pk.w = cvt_pk_bf16(o[6], o[7]);
            *(u32x4*)(UV + off) = pk;
        }
    }
}

__device__ __forceinline__ int crow(int r, int hi) { return (r & 3) + 8 * (r >> 2) + 4 * hi; }
constexpr int KS_PITCH = 144, VS_PITCH = 144, KS_TILE = 64 * KS_PITCH, VS_TILE = 64 * VS_PITCH;
constexpr int ATT_KS = 0, ATT_VS = 4 * KS_TILE, ATT_TB = ATT_VS + 4 * VS_TILE, TB_COPY = 656, ATT_RED = ATT_TB + 2 * 4 * TB_COPY * 4;
static_assert(ATT_RED + 128 <= RING_BYTES && ATT_TB % 16 == 0, "attention LDS map");

__device__ __forceinline__ void attn_phase(LAS unsigned char* lds, const bf16_t* Q, const bf16_t* Kb, const bf16_t* Vt, bf16_t* O, const float* relb, const float* qn, const float* kn, int vcu, int G) {
    int tid = threadIdx.x; asm volatile("" : "+v"(tid));
    const int lane = tid & 63, r32 = lane & 31, hi = lane >> 5, w = __builtin_amdgcn_readfirstlane(tid >> 6), cw = w >> 1, half = w >> 2;
    int cached0 = -1, cached1 = -1;
    float mqk; { float a = fabsf(qn[lane]), b = fabsf(kn[lane]);
#pragma unroll
        for (int o = 1; o < 64; o <<= 1) { a = fmaxf(a, __shfl_xor(a, o)); b = fmaxf(b, __shfl_xor(b, o)); }
        mqk = a * b; }
    const int iq = 32 * (w & 1) + r32;
    const int cpy = (4 - (iq & 3)) & 3;
    const int tb_lane = cpy * (TB_COPY * 4) + (4 * hi + 64 - iq - cpy) * 4;
    const int lr = tid >> 3, pc = tid & 7;
#define ATT_BAR() do { asm volatile("s_waitcnt lgkmcnt(0)" ::: "memory"); __builtin_amdgcn_s_barrier(); asm volatile("" ::: "memory"); } while (0)
#define ATT_LD(j, KR, VR) do { KR = *(const u32x4*)(Kb + (kg0 + (long)(j) * 64 * D)); VR = *(const u32x4*)(Vt + (vg0 + (long)(j) * 64)); } while (0)
#define ATT_ST(j, KR, VR) do { LAS unsigned char* kd_ = lds + ATT_KS + ((j) & 3) * KS_TILE + lr * KS_PITCH + pc * 16; LAS unsigned char* vd_ = lds + ATT_VS + ((j) & 3) * VS_TILE + lr * VS_PITCH + (pc >> 1) * 32 + (pc & 1) * 8;     \
        *(LAS u32x4*)kd_ = KR; *(LAS u32x2*)vd_ = (u32x2){VR.x, VR.y}; *(LAS u32x2*)(vd_ + 16) = (u32x2){VR.z, VR.w}; } while (0)
#define ATT_QK(j, bc, P0, P1) do { const LAS unsigned char* ks_ = lds + ATT_KS + ((j) & 3) * KS_TILE + r32 * KS_PITCH + hi * 16; \
        if ((bc) <= 3) { const float cb_ = tbl[0]; _Pragma("unroll") for (int r = 0; r < 16; ++r) { P0[r] = cb_; P1[r] = cb_; } }     \
        else { const LAS unsigned char* tp_ = (const LAS unsigned char*)tbl + (tb_lane + 256 * (bc)); \
            _Pragma("unroll") for (int g_ = 0; g_ < 4; ++g_) { const f32x4 t0_ = *(const LAS f32x4*)(tp_ + 32 * g_), t1_ = *(const LAS f32x4*)(tp_ + 32 * g_ + 128); \
                _Pragma("unroll") for (int e = 0; e < 4; ++e) { P0[4 * g_ + e] = t0_[e]; P1[4 * g_ + e] = t1_[e]; } } } \
        _Pragma("unroll") for (int d0 = 0; d0 < 4; ++d0) { \
            const bf16x8 a0_ = *(const LAS bf16x8*)(ks_ + d0 * 32), a1_ = *(const LAS bf16x8*)(ks_ + 32 * KS_PITCH + d0 * 32); \
            P0 = __builtin_amdgcn_mfma_f32_32x32x16_bf16(a0_, qr[d0], P0, 0, 0, 0); P1 = __builtin_amdgcn_mfma_f32_32x32x16_bf16(a1_, qr[d0], P1, 0, 0, 0); } } while (0)
#define ATT_SM(P0, P1, PW) do { \
        float ls0_ = 0.f, ls1_ = 0.f; \
        _Pragma("unroll") for (int r = 0; r < 16; ++r) { P0[r] = __builtin_amdgcn_exp2f(P0[r]); P1[r] = __builtin_amdgcn_exp2f(P1[r]); ls0_ += P0[r]; ls1_ += P1[r]; } \
        lrun += ls0_ + ls1_; \
        _Pragma("unroll") for (int s2 = 0; s2 < 2; ++s2) { \
            u32x4 t_; t_.x = cvt_pk_bf16(P0[8 * s2 + 0], P0[8 * s2 + 1]); t_.y = cvt_pk_bf16(P0[8 * s2 + 2], P0[8 * s2 + 3]); t_.z = cvt_pk_bf16(P0[8 * s2 + 4], P0[8 * s2 + 5]); t_.w = cvt_pk_bf16(P0[8 * s2 + 6], P0[8 * s2 + 7]); \
            PW[s2] = __builtin_bit_cast(bf16x8, t_); \
            u32x4 t2_; t2_.x = cvt_pk_bf16(P1[8 * s2 + 0], P1[8 * s2 + 1]); t2_.y = cvt_pk_bf16(P1[8 * s2 + 2], P1[8 * s2 + 3]); t2_.z = cvt_pk_bf16(P1[8 * s2 + 4], P1[8 * s2 + 5]); t2_.w = cvt_pk_bf16(P1[8 * s2 + 6], P1[8 * s2 + 7]); \
            PW[2 + s2] = __builtin_bit_cast(bf16x8, t2_); } } while (0)
#define ATT_PV(j, PW) do { const LAS unsigned char* vs_ = lds + ATT_VS + ((j) & 3) * VS_TILE + r32 * VS_PITCH + hi * 16; \
        _Pragma("unroll") for (int s2 = 0; s2 < 4; ++s2) { \
            const bf16x8 va0_ = *(const LAS bf16x8*)(vs_ + s2 * 32), va1_ = *(const LAS bf16x8*)(vs_ + 32 * VS_PITCH + s2 * 32); \
            o0 = __builtin_amdgcn_mfma_f32_32x32x16_bf16(va0_, PW[s2], o0, 0, 0, 0); o1 = __builtin_amdgcn_mfma_f32_32x32x16_bf16(va1_, PW[s2], o1, 0, 0, 0); } } while (0)
    constexpr int NUNITS = BATCH * NH * (SEQ / 256);
    u32x4 ka = {}, va = {}, kb2 = {}, vb2 = {}, kreg = {}, vreg = {}; bf16x8 qnx[4] = {};
#define ATT_UADDR(Un) const int bh_ = (Un) >> 5, qb_ = (Un) & 31, b_ = bh_ >> 4, h_ = bh_ & 15, jl_ = (qb_ < 2) ? 8 - 4 * qb_ : 0; const long rb_ = (long)b_ * SEQ; \
        const long kq_ = (rb_ + (long)(4 * qb_ - 8) * 64 + lr) * D + h_ * 64 + pc * 8, vq_ = (long)(h_ * 64 + lr) * M + rb_ + (long)(4 * qb_ - 8) * 64 + pc * 8
#define ATT_NEXT(Un, which) do { ATT_UADDR(Un); \
        if ((which) == 0) { ka = *(const u32x4*)(Kb + (kq_ + (long)jl_ * 64 * D)); va = *(const u32x4*)(Vt + (vq_ + (long)jl_ * 64)); } \
        else if ((which) == 1) { kb2 = *(const u32x4*)(Kb + (kq_ + (long)(jl_ + 1) * 64 * D)); vb2 = *(const u32x4*)(Vt + (vq_ + (long)(jl_ + 1) * 64)); } \
        else { kreg = *(const u32x4*)(Kb + (kq_ + (long)(jl_ + 2) * 64 * D)); vreg = *(const u32x4*)(Vt + (vq_ + (long)(jl_ + 2) * 64)); \
            const bf16_t* qp_ = Q + ((size_t)rb_ + (size_t)qb_ * 256 + w * 32 + r32) * D + h_ * 64 + hi * 8; \
            _Pragma("unroll") for (int d0 = 0; d0 < 4; ++d0) qnx[d0] = *(const bf16x8*)(qp_ + d0 * 16); } } while (0)
    if (vcu < NUNITS) { ATT_NEXT(vcu, 0); ATT_NEXT(vcu, 1); ATT_NEXT(vcu, 2); }
    for (int U = vcu; U < NUNITS; U += G) {
        const int bh = U >> 5, qb = U & 31, b = bh >> 4, h = bh & 15;
        const size_t rowbase = (size_t)b * SEQ;
        bf16x8 qr[4];
#pragma unroll
        for (int d0 = 0; d0 < 4; ++d0) qr[d0] = qnx[d0];
        const int slot = h >> 3;
        LAS float* tbl = (LAS float*)(lds + ATT_TB) + slot * (4 * TB_COPY); LAS float* red = (LAS float*)(lds + ATT_RED) + slot * 8;
        __syncthreads();
        if ((slot ? cached1 : cached0) != h) {
            float mb = fabsf(relb[h * 513 + tid]); if (tid == 0) mb = fmaxf(mb, fabsf(relb[h * 513 + 512]));
#pragma unroll
            for (int o = 1; o < 64; o <<= 1) mb = fmaxf(mb, __shfl_xor(mb, o));
            if (lane == 0) red[w] = mb;
            __syncthreads();
            mb = red[0];
#pragma unroll
            for (int i = 1; i < 8; ++i) mb = fmaxf(mb, red[i]);
            const float negB = -(1.02f * 8.f * LOG2E * mqk + LOG2E * mb + 0.1f);
            for (int i = tid; i < 4 * TB_COPY; i += 512) { const int c = i / TB_COPY, z = i % TB_COPY + c; tbl[i] = relb[h * 513 + (z < 320 ? 512 : (z <= 832 ? 832 - z : 0))] * LOG2E + negB; }
            if (slot) cached1 = h; else cached0 = h;
        }
        const int jlo = (qb < 2) ? 8 - 4 * qb : 0;
        const long kg0 = ((long)rowbase + (long)(4 * qb - 8) * 64 + lr) * D + h * 64 + pc * 8;
        const long vg0 = (long)(h * 64 + lr) * M + (long)rowbase + (long)(4 * qb - 8) * 64 + pc * 8;
        ATT_ST(jlo, ka, va); ATT_ST(jlo + 1, kb2, vb2);
        __syncthreads();
        float lrun = 0.f; f32x16 o0 = {}, o1 = {}, sc0 = {}, sc1 = {}; bf16x8 pw[4] = {};
        if (half == 1) ATT_BAR();
        for (int g = jlo; g <= 12; ++g) {
            const int bcg = g - cw, bcp = bcg - 1;
            const bool actg = (g <= 11) && bcg >= 0 && bcg <= 8, actp = (g - 1 >= jlo) && bcp >= 0 && bcp <= 8;
            __builtin_amdgcn_s_setprio(1);
            if (actg) ATT_QK(g, bcg, sc0, sc1);
            if (actp) ATT_PV(g - 1, pw);
            __builtin_amdgcn_s_setprio(0);
            ATT_BAR();
            if (g + 2 <= 11) ATT_ST(g + 2, kreg, vreg);
            if (g + 3 <= 11) ATT_LD(g + 3, kreg, vreg);
            if (g >= 10 && U + G < NUNITS) { if (g == 10) { ATT_NEXT(U + G, 0); ATT_NEXT(U + G, 2); } else if (g == 11) ATT_NEXT(U + G, 1); }
            if (actg) ATT_SM(sc0, sc1, pw);
            ATT_BAR();
        }
        if (half == 0) ATT_BAR();
        const float lt = lrun + __shfl_xor(lrun, 32), il = 1.f / lt;
        bf16_t* op = O + (rowbase + (size_t)qb * 256 + w * 32 + r32) * D + h * 64 + 4 * hi;
#pragma unroll
        for (int gq = 0; gq < 4; ++gq) {
            u32x2 a; a.x = cvt_pk_bf16(o0[4 * gq] * il, o0[4 * gq + 1] * il); a.y = cvt_pk_bf16(o0[4 * gq + 2] * il, o0[4 * gq + 3] * il);
            u32x2 c; c.x = cvt_pk_bf16(o1[4 * gq] * il, o1[4 * gq + 1] * il); c.y = cvt_pk_bf16(o1[4 * gq + 2] * il, o1[4 * gq + 3] * il);
            *(u32x2*)(op + 8 * gq) = a; *(u32x2*)(op + 32 + 8 * gq) = c;
        }
    }
#undef ATT_NEXT
#undef ATT_UADDR
#undef ATT_BAR
#undef ATT_LD
#undef ATT_ST
#undef ATT_QK
#undef ATT_SM
#undef ATT_PV
    __syncthreads();
}

#define XB_TMO      128
#define XB_XCNT(j)  (256  + 64 * (j))
#define XB_XSUB(j)  (1280 + 64 * (j))
#define XB_XGEN(j)  (2304 + 64 * (j))
#define XB_TOP      3328
#define XB_TOPGEN   3392
#define XCD_BAR_WORDS 3456
#define XB_SPIN_CAP (1u << 18)

__device__ __forceinline__ unsigned xb_ld(unsigned* p)              { return __hip_atomic_load(p, __ATOMIC_RELAXED, __HIP_MEMORY_SCOPE_AGENT); }
__device__ __forceinline__ unsigned xb_add(unsigned* p, unsigned v) { return __hip_atomic_fetch_add(p, v, __ATOMIC_RELAXED, __HIP_MEMORY_SCOPE_AGENT); }
__device__ __forceinline__ unsigned xb_xcc_id() { return (unsigned)__builtin_amdgcn_s_getreg((3 << 11) | 20) & 0xFu; }
#define XB_SPIN(cond, bar) do { unsigned _sp = 0; while (cond) { __builtin_amdgcn_s_sleep(1); \
    if ((++_sp & 255u) == 0u) { if (xb_ld(&(bar)[XB_TMO])) break; if (_sp > XB_SPIN_CAP) { atomicAdd(&(bar)[XB_TMO], 1u); break; } } } } while (0)

struct XcdBarrier {
    unsigned* bar; unsigned x;
    volatile LAS unsigned* st;
};

__device__ __forceinline__ XcdBarrier xcd_barrier_post(unsigned* bar, volatile LAS unsigned* st) {
    XcdBarrier b; b.bar = bar; b.x = xb_xcc_id(); b.st = st;
    if (threadIdx.x == 0) (void)xb_add(&bar[XB_XCNT(b.x)], 1u);
    return b;
}
__device__ __forceinline__ void xcd_barrier_complete(unsigned* bar, unsigned x, unsigned& nloc, unsigned& nx) {
    const unsigned G = gridDim.x * gridDim.y * gridDim.z;
    unsigned sum, cnt, mine, sp = 0u;
    for (;;) {
        sum = 0u; cnt = 0u; mine = 0u;
#pragma unroll
        for (unsigned j = 0; j < 16; ++j) { const unsigned c = xb_ld(&bar[XB_XCNT(j)]); sum += c; cnt += (c > 0u) ? 1u : 0u; mine = (j == x) ? c : mine; }
        if (sum == G) break;
        __builtin_amdgcn_s_sleep(1);
        if ((++sp & 255u) == 0u) { if (xb_ld(&bar[XB_TMO])) break; if (sp > XB_SPIN_CAP) { atomicAdd(&bar[XB_TMO], 1u); break; } }
    }
    nloc = mine > 0u ? mine : 1u; nx = cnt > 0u ? cnt : 1u;
}

__device__ __forceinline__ void xcd_barrier(const XcdBarrier& b) {
    asm volatile("s_waitcnt vmcnt(0)" ::: "memory");
    __syncthreads();
    if (threadIdx.x == 0) {
        unsigned* bar = b.bar;
        __builtin_amdgcn_s_waitcnt(0);
        unsigned nloc = b.st[0], nx = b.st[1];
        if (nloc == 0u) { xcd_barrier_complete(bar, b.x, nloc, nx); b.st[0] = nloc; b.st[1] = nx; }
        const unsigned old = xb_add(&bar[XB_XSUB(b.x)], 1u);
        const unsigned gen = old / nloc;
        if (old + 1u == (gen + 1u) * nloc) {
            __builtin_amdgcn_fence(__ATOMIC_RELEASE, "agent");
            asm volatile("s_waitcnt vmcnt(0)" ::: "memory");
            const unsigned og = xb_add(&bar[XB_TOP], 1u);
            const unsigned tg = og / nx;
            if (og + 1u == (tg + 1u) * nx) xb_add(&bar[XB_TOPGEN], 1u);
            else XB_SPIN(xb_ld(&bar[XB_TOPGEN]) == tg, bar);
            __builtin_amdgcn_fence(__ATOMIC_ACQUIRE, "agent");
            xb_add(&bar[XB_XGEN(b.x)], 1u);
            asm volatile("s_waitcnt vmcnt(0)" ::: "memory");
        } else {
            XB_SPIN(xb_ld(&bar[XB_XGEN(b.x)]) == gen, bar);
            __builtin_amdgcn_fence(__ATOMIC_ACQUIRE, "agent");
            asm volatile("s_waitcnt vmcnt(0)" ::: "memory");
        }
    }
    __syncthreads();
}

__global__ void __launch_bounds__(512, 2) fwd_megakernel(Params p) {
    extern __shared__ __attribute__((aligned(16))) unsigned char lds_raw[];
    LAS unsigned char* lds = (LAS unsigned char*)lds_raw;
    LAS float* rs = (LAS float*)(lds + RS_OFF);
    cg::grid_group grid = cg::this_grid();
    { volatile LAS unsigned* misc = (volatile LAS unsigned*)(lds + MISC_OFF); if (threadIdx.x < 2) misc[threadIdx.x] = 0u; }
    __syncthreads();
    const XcdBarrier bar = xcd_barrier_post((unsigned*)(p.ws + WS_CTL), (volatile LAS unsigned*)(lds + MISC_OFF));
    int tid = threadIdx.x; asm volatile("" : "+v"(tid));
    const int lane = tid & 63, wave = __builtin_amdgcn_readfirstlane(tid >> 6);
    const int G = gridDim.x, bx = blockIdx.x;
    const int vcu = (G % 8 == 0) ? (bx % 8) * (G / 8) + bx / 8 : bx;
    unsigned char* ws = p.ws;
    bf16_t* XB = (bf16_t*)(ws + WS_XB); float* SSQ = (float*)(ws + WS_SSQ);

    convert_weights(p, lds, vcu * 8 + wave, G * 8, wave, lane);
    __syncthreads();
    pool_prep<false>(p.x, p.mix_norm, (bf16_t*)(ws + WS_Y), lds, vcu, G);
    if (gridDim.y == 0x7fffffffu) grid.sync();
    xcd_barrier(bar);

    for (int layer = 0; layer < DEPTH; ++layer) {
        const int j = layer >> 1;
        for (int sub = 0; sub < 2; ++sub) {
            pg8::Gemm g; int N_ = D; bool affine = false; const float* ebias = nullptr; const float* escale = nullptr;
            if (sub == 0) {
                if ((layer & 1) == 0) {
                    if (layer > 0) { pool_prep<true>(XB, p.mix_norm + (size_t)layer * D, (bf16_t*)(ws + WS_Y), lds, vcu, G); xcd_barrier(bar); }
                    g = pg8::Gemm{(const bf16_t*)(ws + WS_Y), (const bf16_t*)(ws + WS_POOLW) + (size_t)j * 1024 * 256, 256, D, 256, 256};
                    ebias = p.pool_b + (size_t)j * D; escale = p.pool_scale + (size_t)j * D; affine = true;
                } else {
                    {
                        pg8::StaticOrder S; S.init(M, 2048, G, bx);
                        fill_rstd<4>(rs, SSQ, S, false);
                        pg8::Gemm gq{XB, (const bf16_t*)(ws + WS_WQK) + (size_t)j * 2048 * D, D, D, D, 0};
                        EpiQK Eq{(bf16_t*)(ws + WS_Q), (bf16_t*)(ws + WS_K), p.q_norm + j * 64, p.k_norm + j * 64, rs};
                        pg8::gemm_phase<EpiQK, pg8::StaticOrder>(lds, gq, S, Eq);
                    }
                    {
                        pg8::StaticOrder S; S.init(D, M, G, bx);
                        fill_rstd<2>(rs, SSQ, S, true);
                        pg8::Gemm gv{(const bf16_t*)(ws + WS_WVT) + (size_t)j * D * D, XB, D, D, D, 0};
                        EpiVt Ev{(bf16_t*)(ws + WS_VT), rs};
                        pg8::gemm_phase<EpiVt, pg8::StaticOrder>(lds, gv, S, Ev);
                    }
                    xcd_barrier(bar);
                    attn_phase(lds, (const bf16_t*)(ws + WS_Q), (const bf16_t*)(ws + WS_K), (const bf16_t*)(ws + WS_VT), (bf16_t*)(ws + WS_O), p.rel_bias + (size_t)j * NH * 513, p.q_norm + j * 64, p.k_norm + j * 64, vcu, G);
                    xcd_barrier(bar);
                    g = pg8::Gemm{(const bf16_t*)(ws + WS_O), (const bf16_t*)(ws + WS_WO) + (size_t)j * D * D, D, D, D, 0};
                }
            } else {
                {
                    pg8::StaticOrder S; S.init(M, 2 * FF, G, bx);
                    fill_rstd<11>(rs, SSQ, S, false);
                    pg8::Gemm gu{XB, (const bf16_t*)(ws + WS_WUP) + (size_t)layer * 5632 * D, D, D, D, 0};
                    EpiUpConv Eu{(bf16_t*)(ws + WS_UBUF), rs, (LAS float*)(lds + XCH_OFF), p.conv_w + (size_t)layer * 3 * FF, p.conv_b + (size_t)layer * FF, (float*)(ws + WS_BOT), (float*)(ws + WS_TOPA), (float*)(ws + WS_TOPV)};
                    pg8::gemm_phase<EpiUpConv, pg8::StaticOrder>(lds, gu, S, Eu);
                }
                xcd_barrier(bar);
                {   pg8::StaticOrder S; S.init(M, D, G, bx);
                    conv_fixup(S, (bf16_t*)(ws + WS_UBUF), (const float*)(ws + WS_BOT), (const float*)(ws + WS_TOPA), (const float*)(ws + WS_TOPV), p.conv_w + (size_t)layer * 3 * FF, p.conv_b + (size_t)layer * FF); }
                g = pg8::Gemm{(const bf16_t*)(ws + WS_UBUF), (const bf16_t*)(ws + WS_WOUT) + (size_t)layer * D * FF, FF, FF, FF, 0};
            }
            {
                pg8::StaticOrder S; S.init(M, N_, G, bx);
                if (affine && layer == 0) { EpiRes<true, true, false> Ea{p.x, nullptr, XB, SSQ, ebias, escale}; pg8::gemm_phase<EpiRes<true, true, false>, pg8::StaticOrder>(lds, g, S, Ea); }
                else if (affine) { EpiRes<true, false, false> Ea{nullptr, nullptr, XB, SSQ, ebias, escale}; pg8::gemm_phase<EpiRes<true, false, false>, pg8::StaticOrder>(lds, g, S, Ea); }
                else if (layer == DEPTH - 1 && sub == 1) { EpiRes<false, false, true> Ea{nullptr, p.out, XB, SSQ, nullptr, nullptr}; pg8::gemm_phase<EpiRes<false, false, true>, pg8::StaticOrder>(lds, g, S, Ea); }
                else { EpiRes<false, false, false> Ea{nullptr, nullptr, XB, SSQ, nullptr, nullptr}; pg8::gemm_phase<EpiRes<false, false, false>, pg8::StaticOrder>(lds, g, S, Ea); }
            }
            if (!(layer == DEPTH - 1 && sub == 1)) xcd_barrier(bar);
        }
    }
}

extern "C" void kernel_launch(void* const* d_in, const int* in_sizes, int n_in, void* d_out, int out_size, void* d_ws, size_t ws_size, hipStream_t stream) {
    static int grid = 0;
    if (grid == 0) {
        if (n_in != 16 || in_sizes[0] != M * D || out_size != M * D || ws_size < WS_END) { fprintf(stderr, "kernel_launch: unexpected shapes / workspace (n_in %d, ws %zu, need %zu)\n", n_in, ws_size, (size_t)WS_END); grid = -1; return; }
        int dev = 0, cus = 0, per_cu = 0;
        hipGetDevice(&dev);
        hipDeviceGetAttribute(&cus, hipDeviceAttributeMultiprocessorCount, dev);
        if (hipFuncSetAttribute((const void*)fwd_megakernel, hipFuncAttributeMaxDynamicSharedMemorySize, LDS_BYTES) != hipSuccess) { fprintf(stderr, "kernel_launch: hipFuncSetAttribute failed\n"); grid = -1; return; }
        if (hipOccupancyMaxActiveBlocksPerMultiprocessor(&per_cu, (const void*)fwd_megakernel, 512, LDS_BYTES) != hipSuccess || per_cu < 1) { fprintf(stderr, "kernel_launch: occupancy query failed (%d)\n", per_cu); per_cu = 1; }
        (void)hipGetLastError();
        grid = cus * per_cu;
        if (grid > 256) grid = 256;
        fprintf(stderr, "kernel_launch: grid %d (cus %d x %d)\n", grid, cus, per_cu);
    }
    if (grid < 0) return;
    Params p{};
    p.x = (const float*)d_in[0]; p.mix_norm = (const float*)d_in[1]; p.ffn_norm = (const float*)d_in[2]; p.pool_w = (const float*)d_in[3]; p.pool_b = (const float*)d_in[4];
    p.pool_scale = (const float*)d_in[5]; p.wqkv = (const float*)d_in[6]; p.q_norm = (const float*)d_in[7]; p.k_norm = (const float*)d_in[8]; p.rel_bias = (const float*)d_in[9];
    p.wo = (const float*)d_in[10]; p.w_gate = (const float*)d_in[11]; p.w_val = (const float*)d_in[12]; p.conv_w = (const float*)d_in[13]; p.conv_b = (const float*)d_in[14]; p.w_out = (const float*)d_in[15];
    p.out = (float*)d_out; p.ws = (unsigned char*)d_ws;
    if (hipMemsetAsync((char*)d_ws + WS_CTL, 0, CTL_BYTES, stream) != hipSuccess) { fprintf(stderr, "kernel_launch: hipMemsetAsync failed\n"); return; }
    void* args[] = {&p};
    hipError_t e = hipLaunchCooperativeKernel((const void*)fwd_megakernel, dim3(grid), dim3(512), args, LDS_BYTES, stream);
    if (e != hipSuccess) fprintf(stderr, "kernel_launch: cooperative launch failed: %s (grid %d)\n", hipGetErrorString(e), grid);
}
```

```cpp
#include <hip/hip_runtime.h>
#include <hip/hip_cooperative_groups.h>
#include <cstdio>
#include <cstdint>
namespace cg = cooperative_groups;

#define LAS __attribute__((address_space(3)))
typedef unsigned short bf16_t;
typedef short bf16x8 __attribute__((ext_vector_type(8)));
typedef short s16x4 __attribute__((ext_vector_type(4)));
typedef float f32x4 __attribute__((ext_vector_type(4)));
typedef float f32x2 __attribute__((ext_vector_type(2)));
typedef float f32x16 __attribute__((ext_vector_type(16)));
typedef unsigned u32x4 __attribute__((ext_vector_type(4)));
typedef unsigned u32x2 __attribute__((ext_vector_type(2)));
typedef _Float16 h2 __attribute__((ext_vector_type(2)));

constexpr int D = 1024, BATCH = 4, SEQ = 8192, DEPTH = 4, M = BATCH * SEQ, FF = 2816, NH = 16;
constexpr float EPS = 1e-6f;
constexpr float LOG2E = 1.4426950408889634f;

constexpr size_t MiB = 1u << 20;
constexpr size_t WS_POOLW = 0;
constexpr size_t WS_WQK   = 1 * MiB;
constexpr size_t WS_WVT   = 9 * MiB;
constexpr size_t WS_WO    = 13 * MiB;
constexpr size_t WS_WUP   = 17 * MiB;
constexpr size_t WS_WOUT  = 61 * MiB;
constexpr size_t WS_SSQ   = 83 * MiB;
constexpr size_t WS_XB    = 85 * MiB;
constexpr size_t WS_ACT   = 149 * MiB;
constexpr size_t WS_ABUF  = WS_ACT;
constexpr size_t WS_UBUF  = WS_ACT + 176 * MiB;
constexpr size_t WS_Q     = WS_ACT;
constexpr size_t WS_K     = WS_ACT + 64 * MiB;
constexpr size_t WS_VT    = WS_ACT + 128 * MiB;
constexpr size_t WS_O     = WS_ACT + 192 * MiB;
constexpr size_t WS_Y     = WS_ACT;
constexpr size_t WS_BOT   = WS_ACT;
constexpr size_t WS_TOPA  = WS_ACT + 3 * MiB;
constexpr size_t WS_TOPV  = WS_ACT + 6 * MiB;
constexpr size_t WS_CTL   = WS_ACT + 352 * MiB;
constexpr size_t CTL_BYTES = 65536;
constexpr size_t WS_END   = WS_CTL + CTL_BYTES;

constexpr int RING_BYTES = 131072;
constexpr int RS_OFF = RING_BYTES;
constexpr int XCH_OFF = RS_OFF + 11264;
constexpr int MISC_OFF = XCH_OFF + 4096;
constexpr int LDS_BYTES = 147456;

typedef __bf16 bf16x2_t __attribute__((ext_vector_type(2)));
__device__ __forceinline__ unsigned cvt_pk_bf16(float lo, float hi) { const f32x2 v = {lo, hi}; const bf16x2_t b = __builtin_convertvector(v, bf16x2_t); return __builtin_bit_cast(unsigned, b); }
__device__ __forceinline__ float bf_lo(unsigned w) { return __uint_as_float(w << 16); }
__device__ __forceinline__ float bf_hi(unsigned w) { return __uint_as_float(w & 0xffff0000u); }
__device__ __forceinline__ float wave_sum(float v) {
#pragma unroll
    for (int o = 1; o < 64; o <<= 1) v += __shfl_xor(v, o);
    return v;
}

namespace pg8 {
constexpr int BM = 256, BK = 64, HALF = 128, HTB = HALF * BK * 2, STAGE_BYTES = 8 * HTB, NXCD = 8, WGM = 8;
__host__ __device__ __forceinline__ int lds_byte(int r, int c) { const int st = (r >> 4) * 2 + (c >> 5), rr = r & 15, cc = c & 31, ob = rr * 64 + cc * 2; return st * 1024 + (ob ^ (((ob >> 9) & 1) << 5)); }
__host__ __device__ __forceinline__ void stage_rc(int b, int& R, int& C) { const int st = b / 1024, sb = b % 1024, swz = sb ^ (((sb >> 9) & 1) << 5); R = (st >> 1) * 16 + swz / 64; C = (st & 1) * 32 + (swz % 64) / 2; }
__host__ __device__ __forceinline__ int perm32(int rho) { const int n = rho >> 4, i = rho & 15; return 8 * (i >> 2) + 4 * n + (i & 3); }

struct Unit { int pm, pn; };
struct Gemm { const bf16_t* A; const bf16_t* Bt; int K, lda, ldb, a_pn_off; };

struct StaticOrder {
    int nM, nN, nwg, G, c;
    __host__ __device__ void init(int M_, int N_, int G_, int c_) { nM = M_ / BM; nN = N_ / BM; nwg = nM * nN; G = G_; c = c_; }
    __host__ __device__ bool next(int i, Unit& u) const {
        const long L = (long)i * G + c; if (L >= nwg) return false;
        int wgid = (int)L; { const int q = nwg / NXCD, r = nwg % NXCD, xcd = wgid % NXCD, off = wgid / NXCD; wgid = (xcd < r ? xcd * (q + 1) : r * (q + 1) + (xcd - r) * q) + off; }
        const int nig = WGM * nN, gid = wgid / nig, fm = gid * WGM, gsz = (nM - fm) < WGM ? (nM - fm) : WGM;
        u.pm = fm + ((wgid % nig) % gsz); u.pn = (wgid % nig) / gsz; return true;
    }
};

template <class Epi, class Sched>
__device__ __forceinline__ void gemm_phase(LAS unsigned char* lds, const Gemm g, const Sched& S, const Epi& E) {
    int tid = threadIdx.x; asm volatile("" : "+v"(tid));
    const int wid = __builtin_amdgcn_readfirstlane(tid >> 6), lane = tid & 63, wr = wid >> 2, wc = wid & 3, fr = lane & 15, fq = lane >> 4;
    const int nt = g.K / BK;
    unsigned voffA[2], voffB[2];
#pragma unroll
    for (int i = 0; i < 2; ++i) { int R, C; stage_rc(tid * 16 + i * 8192, R, C); const int Rb = Epi::PERM ? ((R & ~31) + perm32(R & 31)) : R;
        voffA[i] = (unsigned)(R * g.lda + C) * 2u; voffB[i] = (unsigned)(Rb * g.ldb + C) * 2u; }
    asm volatile("" : "+v"(voffA[0]), "+v"(voffA[1]), "+v"(voffB[0]), "+v"(voffB[1]));
    const size_t kstep = (size_t)(BK * 2);
    const size_t hstepA = (size_t)HALF * g.lda * 2, hstepB = (size_t)HALF * g.ldb * 2;
    const size_t tstepA = 2 * hstepA, tstepB = 2 * hstepB;
    const unsigned ldsw = (unsigned)wid * 1024u;
    const int aoff = lds_byte(wr * 64 + fr, fq * 8), boff = lds_byte(wc * 32 + fr, fq * 8);
#define PG8_SA(b, h) (((b) * 2 + (h)) * HTB)
#define PG8_SB(b, h) ((4 + (b) * 2 + (h)) * HTB)
#define PG8_STAGE(bufoff, gbase, voff) do { _Pragma("unroll") for (int _i = 0; _i < 2; ++_i) \
        __builtin_amdgcn_global_load_lds((const unsigned*)((const char*)(gbase) + (voff)[_i]), (LAS unsigned*)(lds + (bufoff) + ldsw + _i * 8192), 16, 0, 0); } while (0)
#define PG8_LDA(dst, b, h) do { _Pragma("unroll") for (int m = 0; m < 4; ++m) _Pragma("unroll") for (int k = 0; k < 2; ++k) dst[m][k] = *(const LAS bf16x8*)(lds + PG8_SA(b, h) + aoff + m * 2048 + k * 1024); } while (0)
#define PG8_LDB(dst, b, h) do { _Pragma("unroll") for (int n = 0; n < 2; ++n) _Pragma("unroll") for (int k = 0; k < 2; ++k) dst[n][k] = *(const LAS bf16x8*)(lds + PG8_SB(b, h) + boff + n * 2048 + k * 1024); } while (0)
#define PG8_MMA(ai, bj, At, Bt) do { __builtin_amdgcn_s_setprio(1); _Pragma("unroll") for (int m = 0; m < 4; ++m) _Pragma("unroll") for (int n = 0; n < 2; ++n) _Pragma("unroll") for (int k = 0; k < 2; ++k) \
        acc[ai][bj][m][n] = __builtin_amdgcn_mfma_f32_16x16x32_bf16(Bt[n][k], At[m][k], acc[ai][bj][m][n], 0, 0, 0); __builtin_amdgcn_s_setprio(0); } while (0)
#define PG8_WAIT_V(n) asm volatile("s_waitcnt vmcnt(" #n ")" ::: "memory")
#define PG8_WAIT_L(n) asm volatile("s_waitcnt lgkmcnt(" #n ")" ::: "memory")
#define PG8_BAR __builtin_amdgcn_s_barrier()
#define PG8_SCHED __builtin_amdgcn_sched_barrier(0)
    Unit cur, nxt; int ui = 0;
    if (!S.next(0, cur)) return;
    f32x4 acc[2][2][4][2];
    E.init(acc, cur, wr, wc, fr, fq);
    bf16x8 At[4][2], B0[2][2], B1[2][2];
    const char* cA = (const char*)g.A + (size_t)cur.pm * tstepA + (size_t)cur.pn * g.a_pn_off * 2; const char* cB = (const char*)g.Bt + (size_t)cur.pn * tstepB;
    PG8_STAGE(PG8_SB(0, 0), cB, voffB); PG8_STAGE(PG8_SB(0, 1), cB + hstepB, voffB); PG8_STAGE(PG8_SA(0, 0), cA, voffA); PG8_STAGE(PG8_SA(0, 1), cA + hstepA, voffA);
    if (wr == 1) PG8_BAR;
    PG8_WAIT_V(2); PG8_BAR;
    PG8_STAGE(PG8_SB(1, 0), cB + kstep, voffB); PG8_STAGE(PG8_SA(1, 0), cA + kstep, voffA); PG8_STAGE(PG8_SB(1, 1), cB + hstepB + kstep, voffB);
    PG8_WAIT_V(6); PG8_BAR;
    for (;;) {
        const bool has_next = S.next(ui + 1, nxt);
        const char* nA = has_next ? (const char*)g.A + (size_t)nxt.pm * tstepA + (size_t)nxt.pn * g.a_pn_off * 2 : cA; const char* nB = has_next ? (const char*)g.Bt + (size_t)nxt.pn * tstepB : cB;
        for (int t = 0; t < nt; t += 2) {
            const bool last = (t == nt - 2);
            const char* a1 = cA + (size_t)(t + 1) * kstep;
            const char* a2 = last ? nA : cA + (size_t)(t + 2) * kstep; const char* b2 = last ? nB : cB + (size_t)(t + 2) * kstep;
            const char* a3 = a2 + kstep; const char* b3 = b2 + kstep;
            PG8_LDB(B0, 0, 0); PG8_LDB(B1, 0, 1); PG8_SCHED; PG8_LDA(At, 0, 0); PG8_STAGE(PG8_SA(1, 1), a1 + hstepA, voffA);
            PG8_WAIT_V(8); PG8_WAIT_L(0); PG8_BAR; PG8_MMA(0, 0, At, B0); PG8_MMA(0, 1, At, B1); PG8_BAR; PG8_SCHED;
            PG8_LDA(At, 0, 1); PG8_STAGE(PG8_SB(0, 0), b2, voffB); PG8_STAGE(PG8_SB(0, 1), b2 + hstepB, voffB); PG8_STAGE(PG8_SA(0, 0), a2, voffA);
            PG8_WAIT_V(8); PG8_WAIT_L(0); PG8_BAR; PG8_MMA(1, 0, At, B0); PG8_MMA(1, 1, At, B1); PG8_BAR; PG8_SCHED;
            PG8_LDB(B0, 1, 0); PG8_LDB(B1, 1, 1); PG8_SCHED; PG8_LDA(At, 1, 0); PG8_STAGE(PG8_SA(0, 1), a2 + hstepA, voffA);
            PG8_WAIT_V(8); PG8_WAIT_L(0); PG8_BAR; PG8_MMA(0, 0, At, B0); PG8_MMA(0, 1, At, B1); PG8_BAR; PG8_SCHED;
            PG8_LDA(At, 1, 1); PG8_STAGE(PG8_SB(1, 0), b3, voffB); PG8_STAGE(PG8_SB(1, 1), b3 + hstepB, voffB); PG8_STAGE(PG8_SA(1, 0), a3, voffA);
            PG8_WAIT_V(8); PG8_WAIT_L(0); PG8_BAR; PG8_MMA(1, 0, At, B0); PG8_MMA(1, 1, At, B1); PG8_BAR; PG8_SCHED;
        }
        if (wr == 0) PG8_BAR;
        E(acc, cur, ui, wr, wc, fr, fq);
        if (!has_next) break;
        E.init(acc, nxt, wr, wc, fr, fq);
        cur = nxt; cA = nA; cB = nB; ++ui;
        if (wr == 1) PG8_BAR;
    }
    PG8_WAIT_V(0);
    PG8_BAR;
#undef PG8_SA
#undef PG8_SB
#undef PG8_STAGE
#undef PG8_LDA
#undef PG8_LDB
#undef PG8_MMA
#undef PG8_WAIT_V
#undef PG8_WAIT_L
#undef PG8_BAR
#undef PG8_SCHED
}
}

__device__ __forceinline__ void acc_zero(f32x4 (&acc)[2][2][4][2]) {
#pragma unroll
    for (int a = 0; a < 2; ++a)
#pragma unroll
        for (int b = 0; b < 2; ++b)
#pragma unroll
            for (int m = 0; m < 4; ++m)
#pragma unroll
                for (int n = 0; n < 2; ++n) acc[a][b][m][n] = (f32x4){0.f, 0.f, 0.f, 0.f};
}
template <bool AFFINE, bool BASE_F32, bool OUT_F32> struct EpiRes {
    static constexpr bool PERM = true;
    const float* base32; float* out32; bf16_t* xb; float* ssqp; const float* bias; const float* scale;
    __device__ __forceinline__ void init(f32x4 (&acc)[2][2][4][2], const pg8::Unit& u, int wr, int wc, int fr, int fq) const {
        const int col0 = u.pn * 256 + wc * 32 + 8 * fq;
        const size_t off0 = (size_t)(u.pm * 256 + wr * 64 + fr) * D + col0;
#pragma unroll
        for (int ai = 0; ai < 2; ++ai)
#pragma unroll
            for (int m = 0; m < 4; ++m)
#pragma unroll
                for (int bj = 0; bj < 2; ++bj) {
                    const size_t off = off0 + (size_t)(ai * 128 + m * 16) * D + bj * 128;
                    if (BASE_F32) { acc[ai][bj][m][0] = *(const f32x4*)(base32 + off); acc[ai][bj][m][1] = *(const f32x4*)(base32 + off + 4); }
                    else { const u32x4 w = *(const u32x4*)(xb + off);
                        acc[ai][bj][m][0] = (f32x4){bf_lo(w.x), bf_hi(w.x), bf_lo(w.y), bf_hi(w.y)}; acc[ai][bj][m][1] = (f32x4){bf_lo(w.z), bf_hi(w.z), bf_lo(w.w), bf_hi(w.w)}; }
                }
        if (AFFINE) {
#pragma unroll
            for (int bj = 0; bj < 2; ++bj)
#pragma unroll
                for (int n = 0; n < 2; ++n) { const f32x4 bs = *(const f32x4*)(bias + col0 + bj * 128 + 4 * n) * *(const f32x4*)(scale + col0 + bj * 128 + 4 * n);
#pragma unroll
                    for (int ai = 0; ai < 2; ++ai)
#pragma unroll
                        for (int m = 0; m < 4; ++m) acc[ai][bj][m][n] += bs; }
        }
    }
    __device__ __forceinline__ void operator()(const f32x4 (&acc)[2][2][4][2], const pg8::Unit& u, int ui, int wr, int wc, int fr, int fq) const {
        const int col0 = u.pn * 256 + wc * 32 + 8 * fq;
#pragma unroll
        for (int ai = 0; ai < 2; ++ai)
#pragma unroll
            for (int m = 0; m < 4; ++m) {
                const int row = u.pm * 256 + ai * 128 + wr * 64 + m * 16 + fr;
                float ss = 0.f;
#pragma unroll
                for (int bj = 0; bj < 2; ++bj) {
                    const size_t off = (size_t)row * D + col0 + bj * 128;
                    const f32x4 o0 = acc[ai][bj][m][0], o1 = acc[ai][bj][m][1];
                    if (OUT_F32) { *(f32x4*)(out32 + off) = o0; *(f32x4*)(out32 + off + 4) = o1; }
                    else {
                        ss += (o0[0] * o0[0] + o0[1] * o0[1]) + (o0[2] * o0[2] + o0[3] * o0[3]) + (o1[0] * o1[0] + o1[1] * o1[1]) + (o1[2] * o1[2] + o1[3] * o1[3]);
                        u32x4 w; w.x = cvt_pk_bf16(o0[0], o0[1]); w.y = cvt_pk_bf16(o0[2], o0[3]); w.z = cvt_pk_bf16(o1[0], o1[1]); w.w = cvt_pk_bf16(o1[2], o1[3]);
                        *(u32x4*)(xb + off) = w; }
                }
                if (!OUT_F32) { ss += __shfl_xor(ss, 16); ss += __shfl_xor(ss, 32);
                    if (fq == 0) ssqp[(size_t)row * 16 + u.pn * 4 + wc] = ss; }
            }
    }
};

struct EpiQK {
    static constexpr bool PERM = true;
    __device__ __forceinline__ void init(f32x4 (&acc)[2][2][4][2], const pg8::Unit&, int, int, int, int) const { acc_zero(acc); }
    bf16_t* Q; bf16_t* Kb; const float* qn; const float* kn; const LAS float* rs;
    __device__ __forceinline__ void operator()(const f32x4 (&acc)[2][2][4][2], const pg8::Unit& u, int ui, int wr, int wc, int fr, int fq) const {
        const bool isq = u.pn < 4; bf16_t* dst = isq ? Q : Kb; const float* nw = isq ? qn : kn; const float sc = isq ? 0.125f * LOG2E : 1.f;
        const int head = (u.pn & 3) * 4 + wc;
        f32x4 w[2][2];
#pragma unroll
        for (int bj = 0; bj < 2; ++bj)
#pragma unroll
            for (int n = 0; n < 2; ++n) w[bj][n] = *(const f32x4*)(nw + 32 * bj + 8 * fq + 4 * n) * sc;
#pragma unroll
        for (int ai = 0; ai < 2; ++ai)
#pragma unroll
            for (int m = 0; m < 4; ++m) {
                const int rl = ai * 128 + wr * 64 + m * 16 + fr;
                const float r = rs[ui * 256 + rl];
                f32x4 v[2][2]; float ss = 0.f;
#pragma unroll
                for (int bj = 0; bj < 2; ++bj)
#pragma unroll
                    for (int n = 0; n < 2; ++n) { v[bj][n] = acc[ai][bj][m][n] * r; const f32x4 x = v[bj][n]; ss += (x[0] * x[0] + x[1] * x[1]) + (x[2] * x[2] + x[3] * x[3]); }
                ss += __shfl_xor(ss, 16); ss += __shfl_xor(ss, 32);
                const float inv = rsqrtf(ss * (1.f / 64.f) + EPS);
#pragma unroll
                for (int bj = 0; bj < 2; ++bj) {
                    const f32x4 o0 = v[bj][0] * inv * w[bj][0], o1 = v[bj][1] * inv * w[bj][1];
                    u32x4 pk; pk.x = cvt_pk_bf16(o0[0], o0[1]); pk.y = cvt_pk_bf16(o0[2], o0[3]); pk.z = cvt_pk_bf16(o1[0], o1[1]); pk.w = cvt_pk_bf16(o1[2], o1[3]);
                    *(u32x4*)(dst + (size_t)(u.pm * 256 + rl) * D + head * 64 + 32 * bj + 8 * fq) = pk;
                }
            }
    }
};

struct EpiVt {
    static constexpr bool PERM = true;
    __device__ __forceinline__ void init(f32x4 (&acc)[2][2][4][2], const pg8::Unit&, int, int, int, int) const { acc_zero(acc); }
    bf16_t* Vt; const LAS float* rs;
    __device__ __forceinline__ void operator()(const f32x4 (&acc)[2][2][4][2], const pg8::Unit& u, int ui, int wr, int wc, int fr, int fq) const {
        f32x4 r[2][2];
#pragma unroll
        for (int bj = 0; bj < 2; ++bj)
#pragma unroll
            for (int n = 0; n < 2; ++n) r[bj][n] = *(const LAS f32x4*)(rs + ui * 256 + bj * 128 + wc * 32 + 8 * fq + 4 * n);
#pragma unroll
        for (int ai = 0; ai < 2; ++ai)
#pragma unroll
            for (int m = 0; m < 4; ++m) {
                const int hd = u.pm * 256 + ai * 128 + wr * 64 + m * 16 + fr;
#pragma unroll
                for (int bj = 0; bj < 2; ++bj) {
                    const f32x4 o0 = acc[ai][bj][m][0] * r[bj][0], o1 = acc[ai][bj][m][1] * r[bj][1];
                    u32x4 pk; pk.x = cvt_pk_bf16(o0[0], o0[1]); pk.y = cvt_pk_bf16(o0[2], o0[3]); pk.z = cvt_pk_bf16(o1[0], o1[1]); pk.w = cvt_pk_bf16(o1[2], o1[3]);
                    *(u32x4*)(Vt + (size_t)hd * M + u.pn * 256 + bj * 128 + wc * 32 + 8 * fq) = pk;
                }
            }
    }
};

struct EpiUp {
    static constexpr bool PERM = true;
    __device__ __forceinline__ void init(f32x4 (&acc)[2][2][4][2], const pg8::Unit&, int, int, int, int) const { acc_zero(acc); }
    bf16_t* Ab; bf16_t* Vb; const LAS float* rs;
    __device__ __forceinline__ void operator()(const f32x4 (&acc)[2][2][4][2], const pg8::Unit& u, int ui, int wr, int wc, int fr, int fq) const {
#pragma unroll
        for (int ai = 0; ai < 2; ++ai)
#pragma unroll
            for (int m = 0; m < 4; ++m) {
                const int rl = ai * 128 + wr * 64 + m * 16 + fr;
                const float r = rs[ui * 256 + rl];
                const size_t off = (size_t)(u.pm * 256 + rl) * FF + u.pn * 128 + wc * 32 + 8 * fq;
#pragma unroll
                for (int bj = 0; bj < 2; ++bj) {
                    const f32x4 o0 = acc[ai][bj][m][0] * r, o1 = acc[ai][bj][m][1] * r;
                    u32x4 pk; pk.x = cvt_pk_bf16(o0[0], o0[1]); pk.y = cvt_pk_bf16(o0[2], o0[3]); pk.z = cvt_pk_bf16(o1[0], o1[1]); pk.w = cvt_pk_bf16(o1[2], o1[3]);
                    *(u32x4*)((bj == 0 ? Ab : Vb) + off) = pk;
                }
            }
    }
};

__device__ __forceinline__ float dpp_ror1(float v) { return __int_as_float(__builtin_amdgcn_mov_dpp(__float_as_int(v), 0x121, 0xf, 0xf, true)); }
__device__ __forceinline__ float dpp_ror2(float v) { return __int_as_float(__builtin_amdgcn_mov_dpp(__float_as_int(v), 0x122, 0xf, 0xf, true)); }
__device__ __forceinline__ float dpp_shr1(float old, float v) { return __int_as_float(__builtin_amdgcn_update_dpp(__float_as_int(old), __float_as_int(v), 0x111, 0xf, 0xf, false)); }
__device__ __forceinline__ float dpp_shr2(float old, float v) { return __int_as_float(__builtin_amdgcn_update_dpp(__float_as_int(old), __float_as_int(v), 0x112, 0xf, 0xf, false)); }
__device__ __forceinline__ float silu_f(float c) { return c * __builtin_amdgcn_rcpf(1.f + __builtin_amdgcn_exp2f(-c * LOG2E)); }
struct EpiUpConv {
    static constexpr bool PERM = true;
    __device__ __forceinline__ void init(f32x4 (&acc)[2][2][4][2], const pg8::Unit&, int, int, int, int) const { acc_zero(acc); }
    bf16_t* U; const LAS float* rs; LAS float* xch; const float* cw; const float* cb; float* bot; float* topa; float* topv;
    __device__ __forceinline__ void operator()(const f32x4 (&acc)[2][2][4][2], const pg8::Unit& u, int ui, int wr, int wc, int fr, int fq) const {
        const int fcol = u.pn * 128 + wc * 32 + 8 * fq;
        f32x4 w0[2], w1[2], w2[2], bb[2];
#pragma unroll
        for (int n = 0; n < 2; ++n) { w0[n] = *(const f32x4*)(cw + fcol + 4 * n); w1[n] = *(const f32x4*)(cw + FF + fcol + 4 * n); w2[n] = *(const f32x4*)(cw + 2 * FF + fcol + 4 * n); bb[n] = *(const f32x4*)(cb + fcol + 4 * n); }
        h2 w0h[2][2], w1h[2][2], w2h[2][2], bbh[2][2];
#pragma unroll
        for (int n = 0; n < 2; ++n)
#pragma unroll
            for (int q = 0; q < 2; ++q) { w0h[n][q] = (h2){(_Float16)w0[n][2 * q], (_Float16)w0[n][2 * q + 1]}; w1h[n][q] = (h2){(_Float16)w1[n][2 * q], (_Float16)w1[n][2 * q + 1]};
                w2h[n][q] = (h2){(_Float16)w2[n][2 * q], (_Float16)w2[n][2 * q + 1]}; bbh[n][q] = (h2){(_Float16)bb[n][2 * q], (_Float16)bb[n][2 * q + 1]}; }
        float rr[2][4];
#pragma unroll
        for (int ai = 0; ai < 2; ++ai)
#pragma unroll
            for (int m = 0; m < 4; ++m) rr[ai][m] = rs[ui * 256 + ai * 128 + wr * 64 + m * 16 + fr];
        if (fr >= 14) {
#pragma unroll
            for (int ai = 0; ai < 2; ++ai)
#pragma unroll
                for (int n = 0; n < 2; ++n) *(LAS f32x4*)(xch + ((ai * 2 + wr) * 4 + wc) * 64 + (fr - 14) * 32 + 8 * fq + 4 * n) = acc[ai][0][3][n] * rr[ai][3];
        }
        asm volatile("s_waitcnt lgkmcnt(0)" ::: "memory"); __builtin_amdgcn_s_barrier(); asm volatile("" ::: "memory");
#pragma unroll
        for (int ai = 0; ai < 2; ++ai) {
            f32x4 pv[2];
            if (ai == 0 && wr == 0) { pv[0] = (f32x4){0.f, 0.f, 0.f, 0.f}; pv[1] = pv[0]; }
            else { const int pai = (wr == 1) ? ai : ai - 1, pwr = wr ^ 1; const int xr = (fr >= 14) ? fr - 14 : 0;
#pragma unroll
                for (int n = 0; n < 2; ++n) pv[n] = *(const LAS f32x4*)(xch + ((pai * 2 + pwr) * 4 + wc) * 64 + xr * 32 + 8 * fq + 4 * n); }
            int t1p[2][2], t2p[2][2];
#pragma unroll
            for (int n = 0; n < 2; ++n)
#pragma unroll
                for (int q = 0; q < 2; ++q) { const int pb = __builtin_bit_cast(int, __builtin_amdgcn_cvt_pkrtz(pv[n][2 * q], pv[n][2 * q + 1]));
                    t1p[n][q] = __builtin_amdgcn_mov_dpp(pb, 0x121, 0xf, 0xf, true); t2p[n][q] = __builtin_amdgcn_mov_dpp(pb, 0x122, 0xf, 0xf, true); }
#pragma unroll
            for (int m = 0; m < 4; ++m) {
                const int rl = ai * 128 + wr * 64 + m * 16 + fr;
                f32x4 a[2], o[2];
#pragma unroll
                for (int n = 0; n < 2; ++n) {
                    a[n] = acc[ai][0][m][n] * rr[ai][m];
                    const f32x4 v = acc[ai][1][m][n] * rr[ai][m];
#pragma unroll
                    for (int q = 0; q < 2; ++q) {
                        const int xb = __builtin_bit_cast(int, __builtin_amdgcn_cvt_pkrtz(a[n][2 * q], a[n][2 * q + 1]));
                        const int t1 = __builtin_amdgcn_mov_dpp(xb, 0x121, 0xf, 0xf, true), t2 = __builtin_amdgcn_mov_dpp(xb, 0x122, 0xf, 0xf, true);
                        const h2 p1 = __builtin_bit_cast(h2, (fr == 0) ? t1p[n][q] : t1), p2 = __builtin_bit_cast(h2, (fr < 2) ? t2p[n][q] : t2), x2 = __builtin_bit_cast(h2, xb);
                        t1p[n][q] = t1; t2p[n][q] = t2;
                        const h2 c = p2 * w0h[n][q] + (p1 * w1h[n][q] + (x2 * w2h[n][q] + bbh[n][q]));
                        const h2 ea = c * (h2){(_Float16)(-LOG2E), (_Float16)(-LOG2E)};
                        h2 ex; ex.x = __builtin_exp2f16(ea.x); ex.y = __builtin_exp2f16(ea.y);
                        const h2 dn = ex + (h2){(_Float16)1.f, (_Float16)1.f};
                        h2 rc; rc.x = __builtin_amdgcn_rcph(dn.x); rc.y = __builtin_amdgcn_rcph(dn.y);
                        const h2 sg = c * rc;
                        o[n][2 * q] = (float)sg.x * v[2 * q]; o[n][2 * q + 1] = (float)sg.y * v[2 * q + 1];
                    }
                }
                u32x4 pk; pk.x = cvt_pk_bf16(o[0][0], o[0][1]); pk.y = cvt_pk_bf16(o[0][2], o[0][3]); pk.z = cvt_pk_bf16(o[1][0], o[1][1]); pk.w = cvt_pk_bf16(o[1][2], o[1][3]);
                *(u32x4*)(U + (size_t)(u.pm * 256 + rl) * FF + fcol) = pk;
                if (ai == 0 && m == 0 && wr == 0 && fr < 2) {
#pragma unroll
                    for (int n = 0; n < 2; ++n) { *(f32x4*)(topa + (size_t)(u.pm * 2 + fr) * FF + fcol + 4 * n) = a[n]; *(f32x4*)(topv + (size_t)(u.pm * 2 + fr) * FF + fcol + 4 * n) = acc[0][1][0][n] * rr[0][0]; }
                }
                if (ai == 1 && m == 3 && wr == 1 && fr >= 14) {
#pragma unroll
                    for (int n = 0; n < 2; ++n) *(f32x4*)(bot + (size_t)(u.pm * 2 + fr - 14) * FF + fcol + 4 * n) = a[n];
                }
            }
        }
    }
};
template <class Sched> __device__ __forceinline__ void conv_fixup(const Sched& S, bf16_t* U, const float* bot, const float* topa, const float* topv, const float* cw, const float* cb) {
    pg8::Unit u; int tid = threadIdx.x; asm volatile("" : "+v"(tid));
    constexpr int NIT = (FF + 511) / 512;
    for (int i = 0; S.next(i, u); ++i) {
        if ((u.pm & 31) == 0) continue;
        float v[NIT][10];
#pragma unroll
        for (int k = 0; k < NIT; ++k) {
            const int f = min(tid + 512 * k, FF - 1);
            v[k][0] = bot[(size_t)((u.pm - 1) * 2) * FF + f]; v[k][1] = bot[(size_t)((u.pm - 1) * 2 + 1) * FF + f];
            v[k][2] = topa[(size_t)(u.pm * 2) * FF + f]; v[k][3] = topa[(size_t)(u.pm * 2 + 1) * FF + f];
            v[k][4] = topv[(size_t)(u.pm * 2) * FF + f]; v[k][5] = topv[(size_t)(u.pm * 2 + 1) * FF + f];
            v[k][6] = cw[f]; v[k][7] = cw[FF + f]; v[k][8] = cw[2 * FF + f]; v[k][9] = cb[f];
        }
#pragma unroll
        for (int k = 0; k < NIT; ++k) {
            const int f = tid + 512 * k;
            const float c0 = v[k][0] * v[k][6] + v[k][1] * v[k][7] + v[k][2] * v[k][8] + v[k][9], c1 = v[k][1] * v[k][6] + v[k][2] * v[k][7] + v[k][3] * v[k][8] + v[k][9];
            const unsigned r0 = cvt_pk_bf16(silu_f(c0) * v[k][4], 0.f), r1 = cvt_pk_bf16(silu_f(c1) * v[k][5], 0.f);
            if (f < FF) { U[(size_t)(u.pm * 256) * FF + f] = (bf16_t)(r0 & 0xffffu); U[(size_t)(u.pm * 256 + 1) * FF + f] = (bf16_t)(r1 & 0xffffu); }
        }
    }
    asm volatile("s_waitcnt vmcnt(0)" ::: "memory");
    __syncthreads();
}

template <int MAXU, class Sched> __device__ __forceinline__ void fill_rstd(LAS float* rs, const float* ssqp, const Sched& S, bool by_pn) {
    pg8::Unit u0; int tid = threadIdx.x; asm volatile("" : "+v"(tid));
    if (S.next(0, u0)) {
        f32x4 a[MAXU], b[MAXU]; bool have[MAXU];
#pragma unroll
        for (int i = 0; i < MAXU; ++i) {
            pg8::Unit u; have[i] = S.next(i, u); if (!have[i]) u = u0;
            const int row = 256 * (by_pn ? u.pn : u.pm) + (tid >> 1);
            const f32x4* p = (const f32x4*)(ssqp + (size_t)row * 16 + (tid & 1) * 8);
            a[i] = p[0]; b[i] = p[1];
        }
#pragma unroll
        for (int i = 0; i < MAXU; ++i) {
            float s = (a[i][0] + a[i][1]) + (a[i][2] + a[i][3]) + (b[i][0] + b[i][1]) + (b[i][2] + b[i][3]);
            s += __shfl_xor(s, 1);
            if (have[i] && !(tid & 1)) rs[i * 256 + (tid >> 1)] = rsqrtf(s * (1.f / D) + EPS);
        }
    }
    __syncthreads();
}

__device__ __forceinline__ void transpose_item(const float* W, int ldn, int k0, int n0, const float* gk, bf16_t* WT, int ldk, int drow0, LAS float* scr, int lane, const float* gn = nullptr) {
    const float gnv = gn ? gn[lane & 31] : 1.f;
    float wv[32];
#pragma unroll
    for (int i = 0; i < 32; ++i) wv[i] = W[(size_t)(k0 + 2 * i + (lane >> 5)) * ldn + n0 + (lane & 31)];
#pragma unroll
    for (int i = 0; i < 32; ++i) { const int kk = 2 * i + (lane >> 5); float v = wv[i] * gnv; if (gk) v *= gk[k0 + kk]; scr[kk * 33 + (lane & 31)] = v; }
    asm volatile("s_waitcnt lgkmcnt(0)" ::: "memory");
    const int c = lane & 7;
#pragma unroll
    for (int j = 0; j < 4; ++j) { const int n = (lane >> 3) + 8 * j; const LAS float* s = scr + (8 * c) * 33 + n;
        u32x4 o; o.x = cvt_pk_bf16(s[0 * 33], s[1 * 33]); o.y = cvt_pk_bf16(s[2 * 33], s[3 * 33]); o.z = cvt_pk_bf16(s[4 * 33], s[5 * 33]); o.w = cvt_pk_bf16(s[6 * 33], s[7 * 33]);
        *(u32x4*)(WT + (size_t)(drow0 + n) * ldk + k0 + 8 * c) = o; }
    asm volatile("s_waitcnt lgkmcnt(0)" ::: "memory");
}

struct Params {
    const float* x; const float* mix_norm; const float* ffn_norm; const float* pool_w; const float* pool_b; const float* pool_scale;
    const float* wqkv; const float* q_norm; const float* k_norm; const float* rel_bias; const float* wo;
    const float* w_gate; const float* w_val; const float* conv_w; const float* conv_b; const float* w_out;
    float* out; unsigned char* ws;
};

__device__ __forceinline__ void convert_weights(const Params& p, LAS unsigned char* lds, int gw, int NGW, int wave, int lane) {
    LAS float* scr = (LAS float*)(lds + wave * 16384);
    constexpr int I_POOL = 2 * 4 * (4 * 8);
    constexpr int I_QKV = 2 * (16 * 96);
    constexpr int I_WO = 2 * (16 * 32);
    constexpr int I_UP = 4 * 2 * (16 * 88);
    constexpr int I_OUT = 4 * (44 * 32);
    constexpr int NITEMS = I_POOL + I_QKV + I_WO + I_UP + I_OUT;
    for (int it = gw; it < NITEMS; it += NGW) {
        int r = it;
        if (r < I_POOL) {
            const int jg = r / 32, q = r % 32, kb = q / 8, nb = q % 8;
            transpose_item(p.pool_w + (size_t)jg * 65536, 256, 64 * kb, 32 * nb, nullptr, (bf16_t*)(p.ws + WS_POOLW) + (size_t)(jg >> 2) * 1024 * 256, 256, (jg & 3) * 256 + 32 * nb, scr, lane, p.pool_scale + (size_t)(jg >> 2) * D + (jg & 3) * 256 + 32 * nb);
            continue; }
        r -= I_POOL;
        if (r < I_QKV) {
            const int j = r / 1536, q = r % 1536, kb = q / 96, nb = q % 96, n0 = 32 * nb;
            const float* W = p.wqkv + (size_t)j * D * 3 * D; const float* gk = p.mix_norm + (size_t)(2 * j + 1) * D;
            if (n0 < 2048) { const int pn = n0 >> 8, nl = n0 & 255, wc = nl >> 6, dd = nl & 63, bj = dd >> 5;
                transpose_item(W, 3 * D, 64 * kb, n0, gk, (bf16_t*)(p.ws + WS_WQK) + (size_t)j * 2048 * D, D, 256 * pn + 128 * bj + 32 * wc, scr, lane); }
            else transpose_item(W, 3 * D, 64 * kb, n0, gk, (bf16_t*)(p.ws + WS_WVT) + (size_t)j * D * D, D, n0 - 2048, scr, lane);
            continue; }
        r -= I_QKV;
        if (r < I_WO) {
            const int j = r / 512, q = r % 512, kb = q / 32, nb = q % 32;
            transpose_item(p.wo + (size_t)j * D * D, D, 64 * kb, 32 * nb, nullptr, (bf16_t*)(p.ws + WS_WO) + (size_t)j * D * D, D, 32 * nb, scr, lane);
            continue; }
        r -= I_WO;
        if (r < I_UP) {
            const int i = r / 2816, q = r % 2816, isval = q / 1408, q2 = q % 1408, kb = q2 / 88, nb = q2 % 88, f0 = 32 * nb;
            const float* W = (isval ? p.w_val : p.w_gate) + (size_t)i * D * FF;
            transpose_item(W, FF, 64 * kb, f0, p.ffn_norm + (size_t)i * D, (bf16_t*)(p.ws + WS_WUP) + (size_t)i * 5632 * D, D, 256 * (f0 >> 7) + 128 * isval + (f0 & 127), scr, lane);
            continue; }
        r -= I_UP;
        {
            const int i = r / 1408, q = r % 1408, kb = q / 32, nb = q % 32;
            transpose_item(p.w_out + (size_t)i * FF * D, D, 64 * kb, 32 * nb, nullptr, (bf16_t*)(p.ws + WS_WOUT) + (size_t)i * D * FF, FF, 32 * nb, scr, lane);
        }
    }
}

template <bool IN_BF16> __device__ __forceinline__ void pool_prep(const void* xin_, const float* g, bf16_t* Y, LAS unsigned char* lds, int vcu, int G) {
    const float* xin = (const float*)xin_; const bf16_t* xinb = (const bf16_t*)xin_;
    LAS float* hs = (LAS float*)lds;
    int tid = threadIdx.x; asm volatile("" : "+v"(tid));
    const int lane = tid & 63, wave = tid >> 6;
    constexpr int RUN = 128;
    for (int run = vcu; run < M / RUN; run += G) {
        for (int k = 0; k < RUN / 16; ++k) {
            const int T0 = run * RUN + k * 16, ts0 = T0 & (SEQ - 1);
            const int nrow = (k == 0) ? 31 : 16, rbase = (k == 0) ? T0 - 15 : T0;
            {
                f32x4 v[4][4];
#pragma unroll
                for (int q = 0; q < 4; ++q) {
                    const int i = wave + 8 * q; const bool ok = (i < nrow) && (((rbase + i) & (SEQ - 1)) <= ts0 + 15) ;
                    const size_t rowo = (size_t)((i < nrow && rbase + i >= 0 && !(ts0 == 0 && k == 0 && i < 15)) ? rbase + i : T0) * D;
                    if (q < 2 || k == 0) {
                        if (IN_BF16) { const u32x2* xr = (const u32x2*)(xinb + rowo) + lane;
#pragma unroll
                            for (int j = 0; j < 4; ++j) { const u32x2 wv = xr[64 * j]; v[q][j] = (f32x4){bf_lo(wv.x), bf_hi(wv.x), bf_lo(wv.y), bf_hi(wv.y)}; } }
                        else { const f32x4* xr = (const f32x4*)(xin + rowo) + lane;
#pragma unroll
                            for (int j = 0; j < 4; ++j) v[q][j] = xr[64 * j]; }
                    }
                    (void)ok;
                }
#pragma unroll
                for (int q = 0; q < 4; ++q) {
                    const int i = wave + 8 * q;
                    if (i < nrow && (q < 2 || k == 0)) {
                        const int row = rbase + i;
                        LAS f32x4* hrow = (LAS f32x4*)(hs + (row & 31) * 1024) + lane;
                        float s = 0.f;
#pragma unroll
                        for (int j = 0; j < 4; ++j) s += (v[q][j][0] * v[q][j][0] + v[q][j][1] * v[q][j][1]) + (v[q][j][2] * v[q][j][2] + v[q][j][3] * v[q][j][3]);
                        float rstd = rsqrtf(wave_sum(s) * (1.f / D) + EPS);
                        if (ts0 == 0 && k == 0 && i < 15) rstd = 0.f;
#pragma unroll
                        for (int j = 0; j < 4; ++j) { const f32x4 gg = *((const f32x4*)g + lane + 64 * j); hrow[64 * j] = v[q][j] * rstd * gg; }
                    }
                }
            }
            __syncthreads();
            {
                const int c = 2 * tid, grp = c >> 8, w = 2 << grp;
                const LAS f32x2* hc = (const LAS f32x2*)(hs + c);
                f32x2 s = (f32x2){0.f, 0.f};
                for (int kk = 1; kk < w; ++kk) s += hc[((T0 - kk) & 31) * 512];
#pragma unroll 4
                for (int r = 0; r < 16; ++r) {
                    const f32x2 hv = hc[((T0 + r) & 31) * 512];
                    s += hv;
                    const int cnt = min(ts0 + r + 1, w);
                    const float ic = 1.f / (float)cnt;
                    const f32x2 y = s * ic - hv;
                    *(unsigned*)(Y + (size_t)(T0 + r) * D + c) = cvt_pk_bf16(y[0], y[1]);
                    s -= hc[((T0 + r - (w - 1)) & 31) * 512];
                }
            }
            __syncthreads();
        }
    }
}

__device__ __forceinline__ void conv_phase(const bf16_t* Ab, bf16_t* UV, const float* cw, const float* cb, int gthread, int nthreads) {
    constexpr int VC = FF / 8, NRUN = (M / 16) * VC;
    for (int run = gthread; run < NRUN; run += nthreads) {
        const int rb = run / VC, vc = run % VC, R0 = rb * 16, f0 = vc * 8;
        float w0[8], w1[8], w2[8], bb[8];
#pragma unroll
        for (int h = 0; h < 2; ++h) {
            const f32x4 a = *(const f32x4*)(cw + f0 + 4 * h), b = *(const f32x4*)(cw + FF + f0 + 4 * h), c = *(const f32x4*)(cw + 2 * FF + f0 + 4 * h), d = *(const f32x4*)(cb + f0 + 4 * h);
#pragma unroll
            for (int e = 0; e < 4; ++e) { w0[4 * h + e] = a[e]; w1[4 * h + e] = b[e]; w2[4 * h + e] = c[e]; bb[4 * h + e] = d[e]; }
        }
        float am2[8], am1[8];
        if ((R0 & (SEQ - 1)) == 0) {
#pragma unroll
            for (int e = 0; e < 8; ++e) { am2[e] = 0.f; am1[e] = 0.f; }
        } else {
            const u32x4 p2 = *(const u32x4*)(Ab + (size_t)(R0 - 2) * FF + f0), p1 = *(const u32x4*)(Ab + (size_t)(R0 - 1) * FF + f0);
#pragma unroll
            for (int e = 0; e < 4; ++e) { am2[2 * e] = bf_lo(p2[e]); am2[2 * e + 1] = bf_hi(p2[e]); am1[2 * e] = bf_lo(p1[e]); am1[2 * e + 1] = bf_hi(p1[e]); }
        }
#pragma unroll 4
        for (int r = 0; r < 16; ++r) {
            const size_t off = (size_t)(R0 + r) * FF + f0;
            const u32x4 pa = *(const u32x4*)(Ab + off), pv = *(const u32x4*)(UV + off);
            float a0[8], vv[8], o[8];
#pragma unroll
            for (int e = 0; e < 4; ++e) { a0[2 * e] = bf_lo(pa[e]); a0[2 * e + 1] = bf_hi(pa[e]); vv[2 * e] = bf_lo(pv[e]); vv[2 * e + 1] = bf_hi(pv[e]); }
#pragma unroll
            for (int e = 0; e < 8; ++e) {
                const float c = am2[e] * w0[e] + am1[e] * w1[e] + a0[e] * w2[e] + bb[e];
                const float sg = __builtin_amdgcn_rcpf(1.f + __builtin_amdgcn_exp2f(-c * LOG2E));
                o[e] = c * sg * vv[e];
                am2[e] = am1[e]; am1[e] = a0[e];
            }
            u32x4 pk; pk.x = cvt_pk_bf16(o[0], o[1]); pk.y = cvt_pk_bf16(o[2], o[3]); pk.z = cvt_pk_bf16(o[4], o[5]); pk.w = cvt_pk_bf16(o[6], o[7]);
            *(u32x4*)(UV + off) = pk;
        }
    }
}

__device__ __forceinline__ int crow(int r, int hi) { return (r & 3) + 8 * (r >> 2) + 4 * hi; }
constexpr int KS_PITCH = 144, VS_PITCH = 144, KS_TILE = 64 * KS_PITCH, VS_TILE = 64 * VS_PITCH;
constexpr int ATT_KS = 0, ATT_VS = 4 * KS_TILE, ATT_TB = ATT_VS + 4 * VS_TILE, TB_COPY = 656, ATT_RED = ATT_TB + 2 * 4 * TB_COPY * 4;
static_assert(ATT_RED + 128 <= RING_BYTES && ATT_TB % 16 == 0, "attention LDS map");

__device__ __forceinline__ void attn_phase(LAS unsigned char* lds, const bf16_t* Q, const bf16_t* Kb, const bf16_t* Vt, bf16_t* O, const float* relb, const float* qn, const float* kn, int vcu, int G) {
    int tid = threadIdx.x; asm volatile("" : "+v"(tid));
    const int lane = tid & 63, r32 = lane & 31, hi = lane >> 5, w = __builtin_amdgcn_readfirstlane(tid >> 6), cw = w >> 1, half = w >> 2;
    int cached0 = -1, cached1 = -1;
    float mqk; { float a = fabsf(qn[lane]), b = fabsf(kn[lane]);
#pragma unroll
        for (int o = 1; o < 64; o <<= 1) { a = fmaxf(a, __shfl_xor(a, o)); b = fmaxf(b, __shfl_xor(b, o)); }
        mqk = a * b; }
    const int iq = 32 * (w & 1) + r32;
    const int cpy = (4 - (iq & 3)) & 3;
    const int tb_lane = cpy * (TB_COPY * 4) + (4 * hi + 64 - iq - cpy) * 4;
    const int lr = tid >> 3, pc = tid & 7;
#define ATT_BAR() do { asm volatile("s_waitcnt lgkmcnt(0)" ::: "memory"); __builtin_amdgcn_s_barrier(); asm volatile("" ::: "memory"); } while (0)
#define ATT_LD(j, KR, VR) do { KR = *(const u32x4*)(Kb + (kg0 + (long)(j) * 64 * D)); VR = *(const u32x4*)(Vt + (vg0 + (long)(j) * 64)); } while (0)
#define ATT_ST(j, KR, VR) do { LAS unsigned char* kd_ = lds + ATT_KS + ((j) & 3) * KS_TILE + lr * KS_PITCH + pc * 16; LAS unsigned char* vd_ = lds + ATT_VS + ((j) & 3) * VS_TILE + lr * VS_PITCH + (pc >> 1) * 32 + (pc & 1) * 8;     \
        *(LAS u32x4*)kd_ = KR; *(LAS u32x2*)vd_ = (u32x2){VR.x, VR.y}; *(LAS u32x2*)(vd_ + 16) = (u32x2){VR.z, VR.w}; } while (0)
#define ATT_KPRE(j, bc, P0, P1) do { const LAS unsigned char* ks_ = lds + ATT_KS + ((j) & 3) * KS_TILE + r32 * KS_PITCH + hi * 16; \
        _Pragma("unroll") for (int d0 = 0; d0 < 4; ++d0) { kf[2 * d0] = *(const LAS bf16x8*)(ks_ + d0 * 32); kf[2 * d0 + 1] = *(const LAS bf16x8*)(ks_ + 32 * KS_PITCH + d0 * 32); } \
        if ((bc) <= 3) { const float cb_ = tbl[0]; _Pragma("unroll") for (int r = 0; r < 16; ++r) { P0[r] = cb_; P1[r] = cb_; } }     \
        else { const LAS unsigned char* tp_ = (const LAS unsigned char*)tbl + (tb_lane + 256 * (bc)); \
            _Pragma("unroll") for (int g_ = 0; g_ < 4; ++g_) { const f32x4 t0_ = *(const LAS f32x4*)(tp_ + 32 * g_), t1_ = *(const LAS f32x4*)(tp_ + 32 * g_ + 128); \
                _Pragma("unroll") for (int e = 0; e < 4; ++e) { P0[4 * g_ + e] = t0_[e]; P1[4 * g_ + e] = t1_[e]; } } } } while (0)
#define ATT_QK(P0, P1) do { _Pragma("unroll") for (int d0 = 0; d0 < 4; ++d0) { \
            P0 = __builtin_amdgcn_mfma_f32_32x32x16_bf16(kf[2 * d0], qr[d0], P0, 0, 0, 0); P1 = __builtin_amdgcn_mfma_f32_32x32x16_bf16(kf[2 * d0 + 1], qr[d0], P1, 0, 0, 0); } } while (0)
#define ATT_SM(P0, P1, PW) do { \
        float ls0_ = 0.f, ls1_ = 0.f; \
        _Pragma("unroll") for (int r = 0; r < 16; ++r) { P0[r] = __builtin_amdgcn_exp2f(P0[r]); P1[r] = __builtin_amdgcn_exp2f(P1[r]); ls0_ += P0[r]; ls1_ += P1[r]; } \
        lrun += ls0_ + ls1_; \
        _Pragma("unroll") for (int s2 = 0; s2 < 2; ++s2) { \
            u32x4 t_; t_.x = cvt_pk_bf16(P0[8 * s2 + 0], P0[8 * s2 + 1]); t_.y = cvt_pk_bf16(P0[8 * s2 + 2], P0[8 * s2 + 3]); t_.z = cvt_pk_bf16(P0[8 * s2 + 4], P0[8 * s2 + 5]); t_.w = cvt_pk_bf16(P0[8 * s2 + 6], P0[8 * s2 + 7]); \
            PW[s2] = __builtin_bit_cast(bf16x8, t_); \
            u32x4 t2_; t2_.x = cvt_pk_bf16(P1[8 * s2 + 0], P1[8 * s2 + 1]); t2_.y = cvt_pk_bf16(P1[8 * s2 + 2], P1[8 * s2 + 3]); t2_.z = cvt_pk_bf16(P1[8 * s2 + 4], P1[8 * s2 + 5]); t2_.w = cvt_pk_bf16(P1[8 * s2 + 6], P1[8 * s2 + 7]); \
            PW[2 + s2] = __builtin_bit_cast(bf16x8, t2_); } } while (0)
#define ATT_PV(j, PW) do { const LAS unsigned char* vs_ = lds + ATT_VS + ((j) & 3) * VS_TILE + r32 * VS_PITCH + hi * 16; \
        _Pragma("unroll") for (int s2 = 0; s2 < 4; ++s2) { \
            const bf16x8 va0_ = *(const LAS bf16x8*)(vs_ + s2 * 32), va1_ = *(const LAS bf16x8*)(vs_ + 32 * VS_PITCH + s2 * 32); \
            o0 = __builtin_amdgcn_mfma_f32_32x32x16_bf16(va0_, PW[s2], o0, 0, 0, 0); o1 = __builtin_amdgcn_mfma_f32_32x32x16_bf16(va1_, PW[s2], o1, 0, 0, 0); } } while (0)
    for (int U = vcu; U < BATCH * NH * (SEQ / 256); U += G) {
        const int bh = U >> 5, qb = U & 31, b = bh >> 4, h = bh & 15;
        const size_t rowbase = (size_t)b * SEQ;
        const int slot = h >> 3;
        LAS float* tbl = (LAS float*)(lds + ATT_TB) + slot * (4 * TB_COPY); LAS float* red = (LAS float*)(lds + ATT_RED) + slot * 8;
        __syncthreads();
        if ((slot ? cached1 : cached0) != h) {
            float mb = fabsf(relb[h * 513 + tid]); if (tid == 0) mb = fmaxf(mb, fabsf(relb[h * 513 + 512]));
#pragma unroll
            for (int o = 1; o < 64; o <<= 1) mb = fmaxf(mb, __shfl_xor(mb, o));
            if (lane == 0) red[w] = mb;
            __syncthreads();
            mb = red[0];
#pragma unroll
            for (int i = 1; i < 8; ++i) mb = fmaxf(mb, red[i]);
            const float negB = -(1.02f * 8.f * LOG2E * mqk + LOG2E * mb + 0.1f);
            for (int i = tid; i < 4 * TB_COPY; i += 512) { const int c = i / TB_COPY, z = i % TB_COPY + c; tbl[i] = relb[h * 513 + (z < 320 ? 512 : (z <= 832 ? 832 - z : 0))] * LOG2E + negB; }
            if (slot) cached1 = h; else cached0 = h;
        }
        const int jlo = (qb < 2) ? 8 - 4 * qb : 0;
        const long kg0 = ((long)rowbase + (long)(4 * qb - 8) * 64 + lr) * D + h * 64 + pc * 8;
        const long vg0 = (long)(h * 64 + lr) * M + (long)rowbase + (long)(4 * qb - 8) * 64 + pc * 8;
        u32x4 kreg, vreg;
        { u32x4 ka, va, kb2, vb2; ATT_LD(jlo, ka, va); ATT_LD(jlo + 1, kb2, vb2); ATT_LD(jlo + 2, kreg, vreg);
          ATT_ST(jlo, ka, va); ATT_ST(jlo + 1, kb2, vb2); }
        bf16x8 qr[4];
        { const bf16_t* qp = Q + (rowbase + (size_t)qb * 256 + w * 32 + r32) * D + h * 64 + hi * 8;
#pragma unroll
          for (int d0 = 0; d0 < 4; ++d0) qr[d0] = *(const bf16x8*)(qp + d0 * 16); }
        __syncthreads();
        float lrun = 0.f; f32x16 o0 = {}, o1 = {}, sc0 = {}, sc1 = {}; bf16x8 pw[4] = {}, kf[8] = {};
        { const int bc0 = jlo - cw; if (bc0 >= 0 && bc0 <= 8) ATT_KPRE(jlo, bc0, sc0, sc1); }
        if (half == 1) ATT_BAR();
        for (int g = jlo; g <= 12; ++g) {
            const int bcg = g - cw, bcp = bcg - 1;
            const bool actg = (g <= 11) && bcg >= 0 && bcg <= 8, actp = (g - 1 >= jlo) && bcp >= 0 && bcp <= 8;
            __builtin_amdgcn_s_setprio(1);
            if (actg) ATT_QK(sc0, sc1);
            if (actp) ATT_PV(g - 1, pw);
            __builtin_amdgcn_s_setprio(0);
            ATT_BAR();
            if (g + 2 <= 11) ATT_ST(g + 2, kreg, vreg);
            if (g + 3 <= 11) ATT_LD(g + 3, kreg, vreg);
            if (actg) ATT_SM(sc0, sc1, pw);
            if (g + 1 <= 11 && bcg + 1 >= 0 && bcg + 1 <= 8) ATT_KPRE(g + 1, bcg + 1, sc0, sc1);
            ATT_BAR();
        }
        if (half == 0) ATT_BAR();
        const float lt = lrun + __shfl_xor(lrun, 32), il = 1.f / lt;
        bf16_t* op = O + (rowbase + (size_t)qb * 256 + w * 32 + r32) * D + h * 64 + 4 * hi;
#pragma unroll
        for (int gq = 0; gq < 4; ++gq) {
            u32x2 a; a.x = cvt_pk_bf16(o0[4 * gq] * il, o0[4 * gq + 1] * il); a.y = cvt_pk_bf16(o0[4 * gq + 2] * il, o0[4 * gq + 3] * il);
            u32x2 c; c.x = cvt_pk_bf16(o1[4 * gq] * il, o1[4 * gq + 1] * il); c.y = cvt_pk_bf16(o1[4 * gq + 2] * il, o1[4 * gq + 3] * il);
            *(u32x2*)(op + 8 * gq) = a; *(u32x2*)(op + 32 + 8 * gq) = c;
        }
    }
#undef ATT_BAR
#undef ATT_LD
#undef ATT_ST
#undef ATT_QK
#undef ATT_KPRE
#undef ATT_SM
#undef ATT_PV
    __syncthreads();
}

#define XB_TMO      128
#define XB_XCNT(j)  (256  + 64 * (j))
#define XB_XSUB(j)  (1280 + 64 * (j))
#define XB_XGEN(j)  (2304 + 64 * (j))
#define XB_TOP      3328
#define XB_TOPGEN   3392
#define XCD_BAR_WORDS 3456
#define XB_SPIN_CAP (1u << 18)

__device__ __forceinline__ unsigned xb_ld(unsigned* p)              { return __hip_atomic_load(p, __ATOMIC_RELAXED, __HIP_MEMORY_SCOPE_AGENT); }
__device__ __forceinline__ unsigned xb_add(unsigned* p, unsigned v) { return __hip_atomic_fetch_add(p, v, __ATOMIC_RELAXED, __HIP_MEMORY_SCOPE_AGENT); }
__device__ __forceinline__ unsigned xb_xcc_id() { return (unsigned)__builtin_amdgcn_s_getreg((3 << 11) | 20) & 0xFu; }
#define XB_SPIN(cond, bar) do { unsigned _sp = 0; while (cond) { __builtin_amdgcn_s_sleep(1); \
    if ((++_sp & 255u) == 0u) { if (xb_ld(&(bar)[XB_TMO])) break; if (_sp > XB_SPIN_CAP) { atomicAdd(&(bar)[XB_TMO], 1u); break; } } } } while (0)

struct XcdBarrier {
    unsigned* bar; unsigned x;
    volatile LAS unsigned* st;
};

__device__ __forceinline__ XcdBarrier xcd_barrier_post(unsigned* bar, volatile LAS unsigned* st) {
    XcdBarrier b; b.bar = bar; b.x = xb_xcc_id(); b.st = st;
    if (threadIdx.x == 0) (void)xb_add(&bar[XB_XCNT(b.x)], 1u);
    return b;
}
__device__ __forceinline__ void xcd_barrier_complete(unsigned* bar, unsigned x, unsigned& nloc, unsigned& nx) {
    const unsigned G = gridDim.x * gridDim.y * gridDim.z;
    unsigned sum, cnt, mine, sp = 0u;
    for (;;) {
        sum = 0u; cnt = 0u; mine = 0u;
#pragma unroll
        for (unsigned j = 0; j < 16; ++j) { const unsigned c = xb_ld(&bar[XB_XCNT(j)]); sum += c; cnt += (c > 0u) ? 1u : 0u; mine = (j == x) ? c : mine; }
        if (sum == G) break;
        __builtin_amdgcn_s_sleep(1);
        if ((++sp & 255u) == 0u) { if (xb_ld(&bar[XB_TMO])) break; if (sp > XB_SPIN_CAP) { atomicAdd(&bar[XB_TMO], 1u); break; } }
    }
    nloc = mine > 0u ? mine : 1u; nx = cnt > 0u ? cnt : 1u;
}

__device__ __forceinline__ void xcd_barrier(const XcdBarrier& b) {
    asm volatile("s_waitcnt vmcnt(0)" ::: "memory");
    __syncthreads();
    if (threadIdx.x == 0) {
        unsigned* bar = b.bar;
        __builtin_amdgcn_s_waitcnt(0);
        unsigned nloc = b.st[0], nx = b.st[1];
        if (nloc == 0u) { xcd_barrier_complete(bar, b.x, nloc, nx); b.st[0] = nloc; b.st[1] = nx; }
        const unsigned old = xb_add(&bar[XB_XSUB(b.x)], 1u);
        const unsigned gen = old / nloc;
        if (old + 1u == (gen + 1u) * nloc) {
            __builtin_amdgcn_fence(__ATOMIC_RELEASE, "agent");
            asm volatile("s_waitcnt vmcnt(0)" ::: "memory");
            const unsigned og = xb_add(&bar[XB_TOP], 1u);
            const unsigned tg = og / nx;
            if (og + 1u == (tg + 1u) * nx) xb_add(&bar[XB_TOPGEN], 1u);
            else XB_SPIN(xb_ld(&bar[XB_TOPGEN]) == tg, bar);
            __builtin_amdgcn_fence(__ATOMIC_ACQUIRE, "agent");
            xb_add(&bar[XB_XGEN(b.x)], 1u);
            asm volatile("s_waitcnt vmcnt(0)" ::: "memory");
        } else {
            XB_SPIN(xb_ld(&bar[XB_XGEN(b.x)]) == gen, bar);
            __builtin_amdgcn_fence(__ATOMIC_ACQUIRE, "agent");
            asm volatile("s_waitcnt vmcnt(0)" ::: "memory");
        }
    }
    __syncthreads();
}

__global__ void __launch_bounds__(512, 2) fwd_megakernel(Params p) {
    extern __shared__ __attribute__((aligned(16))) unsigned char lds_raw[];
    LAS unsigned char* lds = (LAS unsigned char*)lds_raw;
    LAS float* rs = (LAS float*)(lds + RS_OFF);
    cg::grid_group grid = cg::this_grid();
    { volatile LAS unsigned* misc = (volatile LAS unsigned*)(lds + MISC_OFF); if (threadIdx.x < 2) misc[threadIdx.x] = 0u; }
    __syncthreads();
    const XcdBarrier bar = xcd_barrier_post((unsigned*)(p.ws + WS_CTL), (volatile LAS unsigned*)(lds + MISC_OFF));
    int tid = threadIdx.x; asm volatile("" : "+v"(tid));
    const int lane = tid & 63, wave = __builtin_amdgcn_readfirstlane(tid >> 6);
    const int G = gridDim.x, bx = blockIdx.x;
    const int vcu = (G % 8 == 0) ? (bx % 8) * (G / 8) + bx / 8 : bx;
    unsigned char* ws = p.ws;
    bf16_t* XB = (bf16_t*)(ws + WS_XB); float* SSQ = (float*)(ws + WS_SSQ);

    convert_weights(p, lds, vcu * 8 + wave, G * 8, wave, lane);
    __syncthreads();
    pool_prep<false>(p.x, p.mix_norm, (bf16_t*)(ws + WS_Y), lds, vcu, G);
    if (gridDim.y == 0x7fffffffu) grid.sync();
    xcd_barrier(bar);

    for (int layer = 0; layer < DEPTH; ++layer) {
        const int j = layer >> 1;
        for (int sub = 0; sub < 2; ++sub) {
            pg8::Gemm g; int N_ = D; bool affine = false; const float* ebias = nullptr; const float* escale = nullptr;
            if (sub == 0) {
                if ((layer & 1) == 0) {
                    if (layer > 0) { pool_prep<true>(XB, p.mix_norm + (size_t)layer * D, (bf16_t*)(ws + WS_Y), lds, vcu, G); xcd_barrier(bar); }
                    g = pg8::Gemm{(const bf16_t*)(ws + WS_Y), (const bf16_t*)(ws + WS_POOLW) + (size_t)j * 1024 * 256, 256, D, 256, 256};
                    ebias = p.pool_b + (size_t)j * D; escale = p.pool_scale + (size_t)j * D; affine = true;
                } else {
                    {
                        pg8::StaticOrder S; S.init(M, 2048, G, bx);
                        fill_rstd<4>(rs, SSQ, S, false);
                        pg8::Gemm gq{XB, (const bf16_t*)(ws + WS_WQK) + (size_t)j * 2048 * D, D, D, D, 0};
                        EpiQK Eq{(bf16_t*)(ws + WS_Q), (bf16_t*)(ws + WS_K), p.q_norm + j * 64, p.k_norm + j * 64, rs};
                        pg8::gemm_phase<EpiQK, pg8::StaticOrder>(lds, gq, S, Eq);
                    }
                    {
                        pg8::StaticOrder S; S.init(D, M, G, bx);
                        fill_rstd<2>(rs, SSQ, S, true);
                        pg8::Gemm gv{(const bf16_t*)(ws + WS_WVT) + (size_t)j * D * D, XB, D, D, D, 0};
                        EpiVt Ev{(bf16_t*)(ws + WS_VT), rs};
                        pg8::gemm_phase<EpiVt, pg8::StaticOrder>(lds, gv, S, Ev);
                    }
                    xcd_barrier(bar);
                    attn_phase(lds, (const bf16_t*)(ws + WS_Q), (const bf16_t*)(ws + WS_K), (const bf16_t*)(ws + WS_VT), (bf16_t*)(ws + WS_O), p.rel_bias + (size_t)j * NH * 513, p.q_norm + j * 64, p.k_norm + j * 64, vcu, G);
                    xcd_barrier(bar);
                    g = pg8::Gemm{(const bf16_t*)(ws + WS_O), (const bf16_t*)(ws + WS_WO) + (size_t)j * D * D, D, D, D, 0};
                }
            } else {
                {
                    pg8::StaticOrder S; S.init(M, 2 * FF, G, bx);
                    fill_rstd<11>(rs, SSQ, S, false);
                    pg8::Gemm gu{XB, (const bf16_t*)(ws + WS_WUP) + (size_t)layer * 5632 * D, D, D, D, 0};
                    EpiUpConv Eu{(bf16_t*)(ws + WS_UBUF), rs, (LAS float*)(lds + XCH_OFF), p.conv_w + (size_t)layer * 3 * FF, p.conv_b + (size_t)layer * FF, (float*)(ws + WS_BOT), (float*)(ws + WS_TOPA), (float*)(ws + WS_TOPV)};
                    pg8::gemm_phase<EpiUpConv, pg8::StaticOrder>(lds, gu, S, Eu);
                }
                xcd_barrier(bar);
                {   pg8::StaticOrder S; S.init(M, D, G, bx);
                    conv_fixup(S, (bf16_t*)(ws + WS_UBUF), (const float*)(ws + WS_BOT), (const float*)(ws + WS_TOPA), (const float*)(ws + WS_TOPV), p.conv_w + (size_t)layer * 3 * FF, p.conv_b + (size_t)layer * FF); }
                g = pg8::Gemm{(const bf16_t*)(ws + WS_UBUF), (const bf16_t*)(ws + WS_WOUT) + (size_t)layer * D * FF, FF, FF, FF, 0};
            }
            {
                pg8::StaticOrder S; S.init(M, N_, G, bx);
                if (affine && layer == 0) { EpiRes<true, true, false> Ea{p.x, nullptr, XB, SSQ, ebias, escale}; pg8::gemm_phase<EpiRes<true, true, false>, pg8::StaticOrder>(lds, g, S, Ea); }
                else if (affine) { EpiRes<true, false, false> Ea{nullptr, nullptr, XB, SSQ, ebias, escale}; pg8::gemm_phase<EpiRes<true, false, false>, pg8::StaticOrder>(lds, g, S, Ea); }
                else if (layer == DEPTH - 1 && sub == 1) { EpiRes<false, false, true> Ea{nullptr, p.out, XB, SSQ, nullptr, nullptr}; pg8::gemm_phase<EpiRes<false, false, true>, pg8::StaticOrder>(lds, g, S, Ea); }
                else { EpiRes<false, false, false> Ea{nullptr, nullptr, XB, SSQ, nullptr, nullptr}; pg8::gemm_phase<EpiRes<false, false, false>, pg8::StaticOrder>(lds, g, S, Ea); }
            }
            if (!(layer == DEPTH - 1 && sub == 1)) xcd_barrier(bar);
        }
    }
}

extern "C" void kernel_launch(void* const* d_in, const int* in_sizes, int n_in, void* d_out, int out_size, void* d_ws, size_t ws_size, hipStream_t stream) {
    static int grid = 0;
    if (grid == 0) {
        if (n_in != 16 || in_sizes[0] != M * D || out_size != M * D || ws_size < WS_END) { fprintf(stderr, "kernel_launch: unexpected shapes / workspace (n_in %d, ws %zu, need %zu)\n", n_in, ws_size, (size_t)WS_END); grid = -1; return; }
        int dev = 0, cus = 0, per_cu = 0;
        hipGetDevice(&dev);
        hipDeviceGetAttribute(&cus, hipDeviceAttributeMultiprocessorCount, dev);
        if (hipFuncSetAttribute((const void*)fwd_megakernel, hipFuncAttributeMaxDynamicSharedMemorySize, LDS_BYTES) != hipSuccess) { fprintf(stderr, "kernel_launch: hipFuncSetAttribute failed\n"); grid = -1; return; }
        if (hipOccupancyMaxActiveBlocksPerMultiprocessor(&per_cu, (const void*)fwd_megakernel, 512, LDS_BYTES) != hipSuccess || per_cu < 1) { fprintf(stderr, "kernel_launch: occupancy query failed (%d)\n", per_cu); per_cu = 1; }
        (void)hipGetLastError();
        grid = cus * per_cu;
        if (grid > 256) grid = 256;
        fprintf(stderr, "kernel_launch: grid %d (cus %d x %d)\n", grid, cus, per_cu);
    }
    if (grid < 0) return;
    Params p{};
    p.x = (const float*)d_in[0]; p.mix_norm = (const float*)d_in[1]; p.ffn_norm = (const float*)d_in[2]; p.pool_w = (const float*)d_in[3]; p.pool_b = (const float*)d_in[4];
    p.pool_scale = (const float*)d_in[5]; p.wqkv = (const float*)d_in[6]; p.q_norm = (const float*)d_in[7]; p.k_norm = (const float*)d_in[8]; p.rel_bias = (const float*)d_in[9];
    p.wo = (const float*)d_in[10]; p.w_gate = (const float*)d_in[11]; p.w_val = (const float*)d_in[12]; p.conv_w = (const float*)d_in[13]; p.conv_b = (const float*)d_in[14]; p.w_out = (const float*)d_in[15];
    p.out = (float*)d_out; p.ws = (unsigned char*)d_ws;
    if (hipMemsetAsync((char*)d_ws + WS_CTL, 0, CTL_BYTES, stream) != hipSuccess) { fprintf(stderr, "kernel_launch: hipMemsetAsync failed\n"); return; }
    void* args[] = {&p};
    hipError_t e = hipLaunchCooperativeKernel((const void*)fwd_megakernel, dim3(grid), dim3(512), args, LDS_BYTES, stream);
    if (e != hipSuccess) fprintf(stderr, "kernel_launch: cooperative launch failed: %s (grid %d)\n", hipGetErrorString(e), grid);
}
```

```cpp
#include <hip/hip_runtime.h>
#include <hip/hip_cooperative_groups.h>
#include <cstdio>
#include <cstdint>
namespace cg = cooperative_groups;

#define LAS __attribute__((address_space(3)))
typedef unsigned short bf16_t;
typedef short bf16x8 __attribute__((ext_vector_type(8)));
typedef short s16x4 __attribute__((ext_vector_type(4)));
typedef float f32x4 __attribute__((ext_vector_type(4)));
typedef float f32x2 __attribute__((ext_vector_type(2)));
typedef float f32x16 __attribute__((ext_vector_type(16)));
typedef unsigned u32x4 __attribute__((ext_vector_type(4)));
typedef unsigned u32x2 __attribute__((ext_vector_type(2)));
typedef _Float16 h2 __attribute__((ext_vector_type(2)));

constexpr int D = 1024, BATCH = 4, SEQ = 8192, DEPTH = 4, M = BATCH * SEQ, FF = 2816, NH = 16;
constexpr float EPS = 1e-6f;
constexpr float LOG2E = 1.4426950408889634f;

constexpr size_t MiB = 1u << 20;
constexpr size_t WS_POOLW = 0;
constexpr size_t WS_WQK   = 1 * MiB;
constexpr size_t WS_WVT   = 9 * MiB;
constexpr size_t WS_WO    = 13 * MiB;
constexpr size_t WS_WUP   = 17 * MiB;
constexpr size_t WS_WOUT  = 61 * MiB;
constexpr size_t WS_SSQ   = 83 * MiB;
constexpr size_t WS_XB    = 85 * MiB;
constexpr size_t WS_ACT   = 149 * MiB;
constexpr size_t WS_ABUF  = WS_ACT;
constexpr size_t WS_UBUF  = WS_ACT + 176 * MiB;
constexpr size_t WS_Q     = WS_ACT;
constexpr size_t WS_K     = WS_ACT + 64 * MiB;
constexpr size_t WS_VT    = WS_ACT + 128 * MiB;
constexpr size_t WS_O     = WS_ACT + 192 * MiB;
constexpr size_t WS_Y     = WS_ACT;
constexpr size_t WS_BOT   = WS_ACT;
constexpr size_t WS_TOPA  = WS_ACT + 3 * MiB;
constexpr size_t WS_TOPV  = WS_ACT + 6 * MiB;
constexpr size_t WS_CTL   = WS_ACT + 352 * MiB;
constexpr size_t CTL_BYTES = 65536;
constexpr size_t WS_END   = WS_CTL + CTL_BYTES;

constexpr int RING_BYTES = 131072;
constexpr int RS_OFF = RING_BYTES;
constexpr int XCH_OFF = RS_OFF + 11264;
constexpr int MISC_OFF = XCH_OFF + 4096;
constexpr int LDS_BYTES = 147456;

typedef __bf16 bf16x2_t __attribute__((ext_vector_type(2)));
__device__ __forceinline__ unsigned cvt_pk_bf16(float lo, float hi) { const f32x2 v = {lo, hi}; const bf16x2_t b = __builtin_convertvector(v, bf16x2_t); return __builtin_bit_cast(unsigned, b); }
__device__ __forceinline__ float bf_lo(unsigned w) { return __uint_as_float(w << 16); }
__device__ __forceinline__ float bf_hi(unsigned w) { return __uint_as_float(w & 0xffff0000u); }
__device__ __forceinline__ float wave_sum(float v) {
#pragma unroll
    for (int o = 1; o < 64; o <<= 1) v += __shfl_xor(v, o);
    return v;
}

namespace pg8 {
constexpr int BM = 256, BK = 64, HALF = 128, HTB = HALF * BK * 2, STAGE_BYTES = 8 * HTB, NXCD = 8, WGM = 8;
__host__ __device__ __forceinline__ int lds_byte(int r, int c) { const int st = (r >> 4) * 2 + (c >> 5), rr = r & 15, cc = c & 31, ob = rr * 64 + cc * 2; return st * 1024 + (ob ^ (((ob >> 9) & 1) << 5)); }
__host__ __device__ __forceinline__ void stage_rc(int b, int& R, int& C) { const int st = b / 1024, sb = b % 1024, swz = sb ^ (((sb >> 9) & 1) << 5); R = (st >> 1) * 16 + swz / 64; C = (st & 1) * 32 + (swz % 64) / 2; }
__host__ __device__ __forceinline__ int perm32(int rho) { const int n = rho >> 4, i = rho & 15; return 8 * (i >> 2) + 4 * n + (i & 3); }

struct Unit { int pm, pn; };
struct Gemm { const bf16_t* A; const bf16_t* Bt; int K, lda, ldb, a_pn_off; };

struct StaticOrder {
    int nM, nN, nwg, G, c;
    __host__ __device__ void init(int M_, int N_, int G_, int c_) { nM = M_ / BM; nN = N_ / BM; nwg = nM * nN; G = G_; c = c_; }
    __host__ __device__ bool next(int i, Unit& u) const {
        const long L = (long)i * G + c; if (L >= nwg) return false;
        int wgid = (int)L; { const int q = nwg / NXCD, r = nwg % NXCD, xcd = wgid % NXCD, off = wgid / NXCD; wgid = (xcd < r ? xcd * (q + 1) : r * (q + 1) + (xcd - r) * q) + off; }
        const int nig = WGM * nN, gid = wgid / nig, fm = gid * WGM, gsz = (nM - fm) < WGM ? (nM - fm) : WGM;
        u.pm = fm + ((wgid % nig) % gsz); u.pn = (wgid % nig) / gsz; return true;
    }
};

template <class Epi, class Sched>
__device__ __forceinline__ void gemm_phase(LAS unsigned char* lds, const Gemm g, const Sched& S, const Epi& E) {
    int tid = threadIdx.x; asm volatile("" : "+v"(tid));
    const int wid = __builtin_amdgcn_readfirstlane(tid >> 6), lane = tid & 63, wr = wid >> 2, wc = wid & 3, fr = lane & 15, fq = lane >> 4;
    const int nt = g.K / BK;
    unsigned voffA[2], voffB[2];
#pragma unroll
    for (int i = 0; i < 2; ++i) { int R, C; stage_rc(tid * 16 + i * 8192, R, C); const int Rb = Epi::PERM ? ((R & ~31) + perm32(R & 31)) : R;
        voffA[i] = (unsigned)(R * g.lda + C) * 2u; voffB[i] = (unsigned)(Rb * g.ldb + C) * 2u; }
    asm volatile("" : "+v"(voffA[0]), "+v"(voffA[1]), "+v"(voffB[0]), "+v"(voffB[1]));
    const size_t kstep = (size_t)(BK * 2);
    const size_t hstepA = (size_t)HALF * g.lda * 2, hstepB = (size_t)HALF * g.ldb * 2;
    const size_t tstepA = 2 * hstepA, tstepB = 2 * hstepB;
    const unsigned ldsw = (unsigned)wid * 1024u;
    const int aoff = lds_byte(wr * 64 + fr, fq * 8), boff = lds_byte(wc * 32 + fr, fq * 8);
#define PG8_SA(b, h) (((b) * 2 + (h)) * HTB)
#define PG8_SB(b, h) ((4 + (b) * 2 + (h)) * HTB)
#define PG8_STAGE(bufoff, gbase, voff) do { _Pragma("unroll") for (int _i = 0; _i < 2; ++_i) \
        __builtin_amdgcn_global_load_lds((const unsigned*)((const char*)(gbase) + (voff)[_i]), (LAS unsigned*)(lds + (bufoff) + ldsw + _i * 8192), 16, 0, 0); } while (0)
#define PG8_LDA(dst, b, h) do { _Pragma("unroll") for (int m = 0; m < 4; ++m) _Pragma("unroll") for (int k = 0; k < 2; ++k) dst[m][k] = *(const LAS bf16x8*)(lds + PG8_SA(b, h) + aoff + m * 2048 + k * 1024); } while (0)
#define PG8_LDB(dst, b, h) do { _Pragma("unroll") for (int n = 0; n < 2; ++n) _Pragma("unroll") for (int k = 0; k < 2; ++k) dst[n][k] = *(const LAS bf16x8*)(lds + PG8_SB(b, h) + boff + n * 2048 + k * 1024); } while (0)
#define PG8_MMA(ai, bj, At, Bt) do { __builtin_amdgcn_s_setprio(1); _Pragma("unroll") for (int m = 0; m < 4; ++m) _Pragma("unroll") for (int n = 0; n < 2; ++n) _Pragma("unroll") for (int k = 0; k < 2; ++k) \
        acc[ai][bj][m][n] = __builtin_amdgcn_mfma_f32_16x16x32_bf16(Bt[n][k], At[m][k], acc[ai][bj][m][n], 0, 0, 0); __builtin_amdgcn_s_setprio(0); } while (0)
#define PG8_WAIT_V(n) asm volatile("s_waitcnt vmcnt(" #n ")" ::: "memory")
#define PG8_WAIT_L(n) asm volatile("s_waitcnt lgkmcnt(" #n ")" ::: "memory")
#define PG8_BAR __builtin_amdgcn_s_barrier()
#define PG8_SCHED __builtin_amdgcn_sched_barrier(0)
    Unit cur, nxt; int ui = 0;
    if (!S.next(0, cur)) return;
    f32x4 acc[2][2][4][2];
    E.init(acc, cur, wr, wc, fr, fq);
    bf16x8 At[4][2], B0[2][2], B1[2][2];
    const char* cA = (const char*)g.A + (size_t)cur.pm * tstepA + (size_t)cur.pn * g.a_pn_off * 2; const char* cB = (const char*)g.Bt + (size_t)cur.pn * tstepB;
    PG8_STAGE(PG8_SB(0, 0), cB, voffB); PG8_STAGE(PG8_SB(0, 1), cB + hstepB, voffB); PG8_STAGE(PG8_SA(0, 0), cA, voffA); PG8_STAGE(PG8_SA(0, 1), cA + hstepA, voffA);
    if (wr == 1) PG8_BAR;
    PG8_WAIT_V(2); PG8_BAR;
    PG8_STAGE(PG8_SB(1, 0), cB + kstep, voffB); PG8_STAGE(PG8_SA(1, 0), cA + kstep, voffA); PG8_STAGE(PG8_SB(1, 1), cB + hstepB + kstep, voffB);
    PG8_WAIT_V(6); PG8_BAR;
    for (;;) {
        const bool has_next = S.next(ui + 1, nxt);
        const char* nA = has_next ? (const char*)g.A + (size_t)nxt.pm * tstepA + (size_t)nxt.pn * g.a_pn_off * 2 : cA; const char* nB = has_next ? (const char*)g.Bt + (size_t)nxt.pn * tstepB : cB;
        for (int t = 0; t < nt; t += 2) {
            const bool last = (t == nt - 2);
            const char* a1 = cA + (size_t)(t + 1) * kstep;
            const char* a2 = last ? nA : cA + (size_t)(t + 2) * kstep; const char* b2 = last ? nB : cB + (size_t)(t + 2) * kstep;
            const char* a3 = a2 + kstep; const char* b3 = b2 + kstep;
            PG8_LDB(B0, 0, 0); PG8_LDB(B1, 0, 1); PG8_SCHED; PG8_LDA(At, 0, 0); PG8_STAGE(PG8_SA(1, 1), a1 + hstepA, voffA);
            PG8_WAIT_V(8); PG8_WAIT_L(0); PG8_BAR; PG8_MMA(0, 0, At, B0); PG8_MMA(0, 1, At, B1); PG8_BAR; PG8_SCHED;
            PG8_LDA(At, 0, 1); PG8_STAGE(PG8_SB(0, 0), b2, voffB); PG8_STAGE(PG8_SB(0, 1), b2 + hstepB, voffB); PG8_STAGE(PG8_SA(0, 0), a2, voffA);
            PG8_WAIT_V(8); PG8_WAIT_L(0); PG8_BAR; PG8_MMA(1, 0, At, B0); PG8_MMA(1, 1, At, B1); PG8_BAR; PG8_SCHED;
            PG8_LDB(B0, 1, 0); PG8_LDB(B1, 1, 1); PG8_SCHED; PG8_LDA(At, 1, 0); PG8_STAGE(PG8_SA(0, 1), a2 + hstepA, voffA);
            PG8_WAIT_V(8); PG8_WAIT_L(0); PG8_BAR; PG8_MMA(0, 0, At, B0); PG8_MMA(0, 1, At, B1); PG8_BAR; PG8_SCHED;
            PG8_LDA(At, 1, 1); PG8_STAGE(PG8_SB(1, 0), b3, voffB); PG8_STAGE(PG8_SB(1, 1), b3 + hstepB, voffB); PG8_STAGE(PG8_SA(1, 0), a3, voffA);
            PG8_WAIT_V(8); PG8_WAIT_L(0); PG8_BAR; PG8_MMA(1, 0, At, B0); PG8_MMA(1, 1, At, B1); PG8_BAR; PG8_SCHED;
        }
        if (wr == 0) PG8_BAR;
        E(acc, cur, ui, wr, wc, fr, fq);
        if (!has_next) break;
        E.init(acc, nxt, wr, wc, fr, fq);
        cur = nxt; cA = nA; cB = nB; ++ui;
        if (wr == 1) PG8_BAR;
    }
    PG8_WAIT_V(0);
    PG8_BAR;
#undef PG8_SA
#undef PG8_SB
#undef PG8_STAGE
#undef PG8_LDA
#undef PG8_LDB
#undef PG8_MMA
#undef PG8_WAIT_V
#undef PG8_WAIT_L
#undef PG8_BAR
#undef PG8_SCHED
}
}

__device__ __forceinline__ void acc_zero(f32x4 (&acc)[2][2][4][2]) {
#pragma unroll
    for (int a = 0; a < 2; ++a)
#pragma unroll
        for (int b = 0; b < 2; ++b)
#pragma unroll
            for (int m = 0; m < 4; ++m)
#pragma unroll
                for (int n = 0; n < 2; ++n) acc[a][b][m][n] = (f32x4){0.f, 0.f, 0.f, 0.f};
}
template <bool AFFINE, bool BASE_F32, bool OUT_F32> struct EpiRes {
    static constexpr bool PERM = true;
    const float* base32; float* out32; bf16_t* xb; float* ssqp; const float* bias; const float* scale;
    __device__ __forceinline__ void init(f32x4 (&acc)[2][2][4][2], const pg8::Unit& u, int wr, int wc, int fr, int fq) const {
        const int col0 = u.pn * 256 + wc * 32 + 8 * fq;
        const size_t off0 = (size_t)(u.pm * 256 + wr * 64 + fr) * D + col0;
#pragma unroll
        for (int ai = 0; ai < 2; ++ai)
#pragma unroll
            for (int m = 0; m < 4; ++m)
#pragma unroll
                for (int bj = 0; bj < 2; ++bj) {
                    const size_t off = off0 + (size_t)(ai * 128 + m * 16) * D + bj * 128;
                    if (BASE_F32) { acc[ai][bj][m][0] = *(const f32x4*)(base32 + off); acc[ai][bj][m][1] = *(const f32x4*)(base32 + off + 4); }
                    else { const u32x4 w = *(const u32x4*)(xb + off);
                        acc[ai][bj][m][0] = (f32x4){bf_lo(w.x), bf_hi(w.x), bf_lo(w.y), bf_hi(w.y)}; acc[ai][bj][m][1] = (f32x4){bf_lo(w.z), bf_hi(w.z), bf_lo(w.w), bf_hi(w.w)}; }
                }
        if (AFFINE) {
#pragma unroll
            for (int bj = 0; bj < 2; ++bj)
#pragma unroll
                for (int n = 0; n < 2; ++n) { const f32x4 bs = *(const f32x4*)(bias + col0 + bj * 128 + 4 * n) * *(const f32x4*)(scale + col0 + bj * 128 + 4 * n);
#pragma unroll
                    for (int ai = 0; ai < 2; ++ai)
#pragma unroll
                        for (int m = 0; m < 4; ++m) acc[ai][bj][m][n] += bs; }
        }
    }
    __device__ __forceinline__ void operator()(const f32x4 (&acc)[2][2][4][2], const pg8::Unit& u, int ui, int wr, int wc, int fr, int fq) const {
        const int col0 = u.pn * 256 + wc * 32 + 8 * fq;
#pragma unroll
        for (int ai = 0; ai < 2; ++ai)
#pragma unroll
            for (int m = 0; m < 4; ++m) {
                const int row = u.pm * 256 + ai * 128 + wr * 64 + m * 16 + fr;
                float ss = 0.f;
#pragma unroll
                for (int bj = 0; bj < 2; ++bj) {
                    const size_t off = (size_t)row * D + col0 + bj * 128;
                    const f32x4 o0 = acc[ai][bj][m][0], o1 = acc[ai][bj][m][1];
                    if (OUT_F32) { *(f32x4*)(out32 + off) = o0; *(f32x4*)(out32 + off + 4) = o1; }
                    else {
                        ss += (o0[0] * o0[0] + o0[1] * o0[1]) + (o0[2] * o0[2] + o0[3] * o0[3]) + (o1[0] * o1[0] + o1[1] * o1[1]) + (o1[2] * o1[2] + o1[3] * o1[3]);
                        u32x4 w; w.x = cvt_pk_bf16(o0[0], o0[1]); w.y = cvt_pk_bf16(o0[2], o0[3]); w.z = cvt_pk_bf16(o1[0], o1[1]); w.w = cvt_pk_bf16(o1[2], o1[3]);
                        *(u32x4*)(xb + off) = w; }
                }
                if (!OUT_F32) { ss += __shfl_xor(ss, 16); ss += __shfl_xor(ss, 32);
                    if (fq == 0) ssqp[(size_t)row * 16 + u.pn * 4 + wc] = ss; }
            }
    }
};

struct EpiQK {
    static constexpr bool PERM = true;
    __device__ __forceinline__ void init(f32x4 (&acc)[2][2][4][2], const pg8::Unit&, int, int, int, int) const { acc_zero(acc); }
    bf16_t* Q; bf16_t* Kb; const float* qn; const float* kn; const LAS float* rs;
    __device__ __forceinline__ void operator()(const f32x4 (&acc)[2][2][4][2], const pg8::Unit& u, int ui, int wr, int wc, int fr, int fq) const {
        const bool isq = u.pn < 4; bf16_t* dst = isq ? Q : Kb; const float* nw = isq ? qn : kn; const float sc = isq ? 0.125f * LOG2E : 1.f;
        const int head = (u.pn & 3) * 4 + wc;
        f32x4 w[2][2];
#pragma unroll
        for (int bj = 0; bj < 2; ++bj)
#pragma unroll
            for (int n = 0; n < 2; ++n) w[bj][n] = *(const f32x4*)(nw + 32 * bj + 8 * fq + 4 * n) * sc;
#pragma unroll
        for (int ai = 0; ai < 2; ++ai)
#pragma unroll
            for (int m = 0; m < 4; ++m) {
                const int rl = ai * 128 + wr * 64 + m * 16 + fr;
                const float r = rs[ui * 256 + rl];
                f32x4 v[2][2]; float ss = 0.f;
#pragma unroll
                for (int bj = 0; bj < 2; ++bj)
#pragma unroll
                    for (int n = 0; n < 2; ++n) { v[bj][n] = acc[ai][bj][m][n] * r; const f32x4 x = v[bj][n]; ss += (x[0] * x[0] + x[1] * x[1]) + (x[2] * x[2] + x[3] * x[3]); }
                ss += __shfl_xor(ss, 16); ss += __shfl_xor(ss, 32);
                const float inv = rsqrtf(ss * (1.f / 64.f) + EPS);
#pragma unroll
                for (int bj = 0; bj < 2; ++bj) {
                    const f32x4 o0 = v[bj][0] * inv * w[bj][0], o1 = v[bj][1] * inv * w[bj][1];
                    u32x4 pk; pk.x = cvt_pk_bf16(o0[0], o0[1]); pk.y = cvt_pk_bf16(o0[2], o0[3]); pk.z = cvt_pk_bf16(o1[0], o1[1]); pk.w = cvt_pk_bf16(o1[2], o1[3]);
                    *(u32x4*)(dst + (size_t)(u.pm * 256 + rl) * D + head * 64 + 32 * bj + 8 * fq) = pk;
                }
            }
    }
};

struct EpiVt {
    static constexpr bool PERM = true;
    __device__ __forceinline__ void init(f32x4 (&acc)[2][2][4][2], const pg8::Unit&, int, int, int, int) const { acc_zero(acc); }
    bf16_t* Vt; const LAS float* rs;
    __device__ __forceinline__ void operator()(const f32x4 (&acc)[2][2][4][2], const pg8::Unit& u, int ui, int wr, int wc, int fr, int fq) const {
        f32x4 r[2][2];
#pragma unroll
        for (int bj = 0; bj < 2; ++bj)
#pragma unroll
            for (int n = 0; n < 2; ++n) r[bj][n] = *(const LAS f32x4*)(rs + ui * 256 + bj * 128 + wc * 32 + 8 * fq + 4 * n);
#pragma unroll
        for (int ai = 0; ai < 2; ++ai)
#pragma unroll
            for (int m = 0; m < 4; ++m) {
                const int hd = u.pm * 256 + ai * 128 + wr * 64 + m * 16 + fr;
#pragma unroll
                for (int bj = 0; bj < 2; ++bj) {
                    const f32x4 o0 = acc[ai][bj][m][0] * r[bj][0], o1 = acc[ai][bj][m][1] * r[bj][1];
                    u32x4 pk; pk.x = cvt_pk_bf16(o0[0], o0[1]); pk.y = cvt_pk_bf16(o0[2], o0[3]); pk.z = cvt_pk_bf16(o1[0], o1[1]); pk.w = cvt_pk_bf16(o1[2], o1[3]);
                    *(u32x4*)(Vt + (size_t)hd * M + u.pn * 256 + bj * 128 + wc * 32 + 8 * fq) = pk;
                }
            }
    }
};

struct EpiUp {
    static constexpr bool PERM = true;
    __device__ __forceinline__ void init(f32x4 (&acc)[2][2][4][2], const pg8::Unit&, int, int, int, int) const { acc_zero(acc); }
    bf16_t* Ab; bf16_t* Vb; const LAS float* rs;
    __device__ __forceinline__ void operator()(const f32x4 (&acc)[2][2][4][2], const pg8::Unit& u, int ui, int wr, int wc, int fr, int fq) const {
#pragma unroll
        for (int ai = 0; ai < 2; ++ai)
#pragma unroll
            for (int m = 0; m < 4; ++m) {
                const int rl = ai * 128 + wr * 64 + m * 16 + fr;
                const float r = rs[ui * 256 + rl];
                const size_t off = (size_t)(u.pm * 256 + rl) * FF + u.pn * 128 + wc * 32 + 8 * fq;
#pragma unroll
                for (int bj = 0; bj < 2; ++bj) {
                    const f32x4 o0 = acc[ai][bj][m][0] * r, o1 = acc[ai][bj][m][1] * r;
                    u32x4 pk; pk.x = cvt_pk_bf16(o0[0], o0[1]); pk.y = cvt_pk_bf16(o0[2], o0[3]); pk.z = cvt_pk_bf16(o1[0], o1[1]); pk.w = cvt_pk_bf16(o1[2], o1[3]);
                    *(u32x4*)((bj == 0 ? Ab : Vb) + off) = pk;
                }
            }
    }
};

__device__ __forceinline__ float dpp_ror1(float v) { return __int_as_float(__builtin_amdgcn_mov_dpp(__float_as_int(v), 0x121, 0xf, 0xf, true)); }
__device__ __forceinline__ float dpp_ror2(float v) { return __int_as_float(__builtin_amdgcn_mov_dpp(__float_as_int(v), 0x122, 0xf, 0xf, true)); }
__device__ __forceinline__ float dpp_shr1(float old, float v) { return __int_as_float(__builtin_amdgcn_update_dpp(__float_as_int(old), __float_as_int(v), 0x111, 0xf, 0xf, false)); }
__device__ __forceinline__ float dpp_shr2(float old, float v) { return __int_as_float(__builtin_amdgcn_update_dpp(__float_as_int(old), __float_as_int(v), 0x112, 0xf, 0xf, false)); }
__device__ __forceinline__ float silu_f(float c) { return c * __builtin_amdgcn_rcpf(1.f + __builtin_amdgcn_exp2f(-c * LOG2E)); }
struct EpiUpConv {
    static constexpr bool PERM = true;
    __device__ __forceinline__ void init(f32x4 (&acc)[2][2][4][2], const pg8::Unit&, int, int, int, int) const { acc_zero(acc); }
    bf16_t* U; const LAS float* rs; LAS float* xch; const float* cw; const float* cb; float* bot; float* topa; float* topv;
    __device__ __forceinline__ void operator()(const f32x4 (&acc)[2][2][4][2], const pg8::Unit& u, int ui, int wr, int wc, int fr, int fq) const {
        const int fcol = u.pn * 128 + wc * 32 + 8 * fq;
        f32x4 w0[2], w1[2], w2[2], bb[2];
#pragma unroll
        for (int n = 0; n < 2; ++n) { w0[n] = *(const f32x4*)(cw + fcol + 4 * n); w1[n] = *(const f32x4*)(cw + FF + fcol + 4 * n); w2[n] = *(const f32x4*)(cw + 2 * FF + fcol + 4 * n); bb[n] = *(const f32x4*)(cb + fcol + 4 * n); }
        h2 w0h[2][2], w1h[2][2], w2h[2][2], bbh[2][2];
#pragma unroll
        for (int n = 0; n < 2; ++n)
#pragma unroll
            for (int q = 0; q < 2; ++q) { w0h[n][q] = (h2){(_Float16)w0[n][2 * q], (_Float16)w0[n][2 * q + 1]}; w1h[n][q] = (h2){(_Float16)w1[n][2 * q], (_Float16)w1[n][2 * q + 1]};
                w2h[n][q] = (h2){(_Float16)w2[n][2 * q], (_Float16)w2[n][2 * q + 1]}; bbh[n][q] = (h2){(_Float16)bb[n][2 * q], (_Float16)bb[n][2 * q + 1]}; }
        float rr[2][4];
#pragma unroll
        for (int ai = 0; ai < 2; ++ai)
#pragma unroll
            for (int m = 0; m < 4; ++m) rr[ai][m] = rs[ui * 256 + ai * 128 + wr * 64 + m * 16 + fr];
        if (fr >= 14) {
#pragma unroll
            for (int ai = 0; ai < 2; ++ai)
#pragma unroll
                for (int n = 0; n < 2; ++n) *(LAS f32x4*)(xch + ((ai * 2 + wr) * 4 + wc) * 64 + (fr - 14) * 32 + 8 * fq + 4 * n) = acc[ai][0][3][n] * rr[ai][3];
        }
        asm volatile("s_waitcnt lgkmcnt(0)" ::: "memory"); __builtin_amdgcn_s_barrier(); asm volatile("" ::: "memory");
#pragma unroll
        for (int ai = 0; ai < 2; ++ai) {
            f32x4 pv[2];
            if (ai == 0 && wr == 0) { pv[0] = (f32x4){0.f, 0.f, 0.f, 0.f}; pv[1] = pv[0]; }
            else { const int pai = (wr == 1) ? ai : ai - 1, pwr = wr ^ 1; const int xr = (fr >= 14) ? fr - 14 : 0;
#pragma unroll
                for (int n = 0; n < 2; ++n) pv[n] = *(const LAS f32x4*)(xch + ((pai * 2 + pwr) * 4 + wc) * 64 + xr * 32 + 8 * fq + 4 * n); }
            int t1p[2][2], t2p[2][2];
#pragma unroll
            for (int n = 0; n < 2; ++n)
#pragma unroll
                for (int q = 0; q < 2; ++q) { const int pb = __builtin_bit_cast(int, __builtin_amdgcn_cvt_pkrtz(pv[n][2 * q], pv[n][2 * q + 1]));
                    t1p[n][q] = __builtin_amdgcn_mov_dpp(pb, 0x121, 0xf, 0xf, true); t2p[n][q] = __builtin_amdgcn_mov_dpp(pb, 0x122, 0xf, 0xf, true); }
#pragma unroll
            for (int m = 0; m < 4; ++m) {
                const int rl = ai * 128 + wr * 64 + m * 16 + fr;
                f32x4 a[2], o[2];
#pragma unroll
                for (int n = 0; n < 2; ++n) {
                    a[n] = acc[ai][0][m][n] * rr[ai][m];
                    const f32x4 v = acc[ai][1][m][n] * rr[ai][m];
#pragma unroll
                    for (int q = 0; q < 2; ++q) {
                        const int xb = __builtin_bit_cast(int, __builtin_amdgcn_cvt_pkrtz(a[n][2 * q], a[n][2 * q + 1]));
                        const int t1 = __builtin_amdgcn_mov_dpp(xb, 0x121, 0xf, 0xf, true), t2 = __builtin_amdgcn_mov_dpp(xb, 0x122, 0xf, 0xf, true);
                        const h2 p1 = __builtin_bit_cast(h2, (fr == 0) ? t1p[n][q] : t1), p2 = __builtin_bit_cast(h2, (fr < 2) ? t2p[n][q] : t2), x2 = __builtin_bit_cast(h2, xb);
                        t1p[n][q] = t1; t2p[n][q] = t2;
                        const h2 c = p2 * w0h[n][q] + (p1 * w1h[n][q] + (x2 * w2h[n][q] + bbh[n][q]));
                        const h2 ea = c * (h2){(_Float16)(-LOG2E), (_Float16)(-LOG2E)};
                        h2 ex; ex.x = __builtin_exp2f16(ea.x); ex.y = __builtin_exp2f16(ea.y);
                        const h2 dn = ex + (h2){(_Float16)1.f, (_Float16)1.f};
                        h2 rc; rc.x = __builtin_amdgcn_rcph(dn.x); rc.y = __builtin_amdgcn_rcph(dn.y);
                        const h2 sg = c * rc;
                        o[n][2 * q] = (float)sg.x * v[2 * q]; o[n][2 * q + 1] = (float)sg.y * v[2 * q + 1];
                    }
                }
                u32x4 pk; pk.x = cvt_pk_bf16(o[0][0], o[0][1]); pk.y = cvt_pk_bf16(o[0][2], o[0][3]); pk.z = cvt_pk_bf16(o[1][0], o[1][1]); pk.w = cvt_pk_bf16(o[1][2], o[1][3]);
                *(u32x4*)(U + (size_t)(u.pm * 256 + rl) * FF + fcol) = pk;
                if (ai == 0 && m == 0 && wr == 0 && fr < 2) {
#pragma unroll
                    for (int n = 0; n < 2; ++n) { *(f32x4*)(topa + (size_t)(u.pm * 2 + fr) * FF + fcol + 4 * n) = a[n]; *(f32x4*)(topv + (size_t)(u.pm * 2 + fr) * FF + fcol + 4 * n) = acc[0][1][0][n] * rr[0][0]; }
                }
                if (ai == 1 && m == 3 && wr == 1 && fr >= 14) {
#pragma unroll
                    for (int n = 0; n < 2; ++n) *(f32x4*)(bot + (size_t)(u.pm * 2 + fr - 14) * FF + fcol + 4 * n) = a[n];
                }
            }
        }
    }
};
template <class Sched> __device__ __forceinline__ void conv_fixup(const Sched& S, bf16_t* U, const float* bot, const float* topa, const float* topv, const float* cw, const float* cb) {
    pg8::Unit u; int tid = threadIdx.x; asm volatile("" : "+v"(tid));
    constexpr int NIT = (FF + 511) / 512;
    for (int i = 0; S.next(i, u); ++i) {
        if ((u.pm & 31) == 0) continue;
        float v[NIT][10];
#pragma unroll
        for (int k = 0; k < NIT; ++k) {
            const int f = min(tid + 512 * k, FF - 1);
            v[k][0] = bot[(size_t)((u.pm - 1) * 2) * FF + f]; v[k][1] = bot[(size_t)((u.pm - 1) * 2 + 1) * FF + f];
            v[k][2] = topa[(size_t)(u.pm * 2) * FF + f]; v[k][3] = topa[(size_t)(u.pm * 2 + 1) * FF + f];
            v[k][4] = topv[(size_t)(u.pm * 2) * FF + f]; v[k][5] = topv[(size_t)(u.pm * 2 + 1) * FF + f];
            v[k][6] = cw[f]; v[k][7] = cw[FF + f]; v[k][8] = cw[2 * FF + f]; v[k][9] = cb[f];
        }
#pragma unroll
        for (int k = 0; k < NIT; ++k) {
            const int f = tid + 512 * k;
            const float c0 = v[k][0] * v[k][6] + v[k][1] * v[k][7] + v[k][2] * v[k][8] + v[k][9], c1 = v[k][1] * v[k][6] + v[k][2] * v[k][7] + v[k][3] * v[k][8] + v[k][9];
            const unsigned r0 = cvt_pk_bf16(silu_f(c0) * v[k][4], 0.f), r1 = cvt_pk_bf16(silu_f(c1) * v[k][5], 0.f);
            if (f < FF) { U[(size_t)(u.pm * 256) * FF + f] = (bf16_t)(r0 & 0xffffu); U[(size_t)(u.pm * 256 + 1) * FF + f] = (bf16_t)(r1 & 0xffffu); }
        }
    }
    asm volatile("s_waitcnt vmcnt(0)" ::: "memory");
    __syncthreads();
}

template <int MAXU, class Sched> __device__ __forceinline__ void fill_rstd(LAS float* rs, const float* ssqp, const Sched& S, bool by_pn) {
    pg8::Unit u0; int tid = threadIdx.x; asm volatile("" : "+v"(tid));
    if (S.next(0, u0)) {
        f32x4 a[MAXU], b[MAXU]; bool have[MAXU];
#pragma unroll
        for (int i = 0; i < MAXU; ++i) {
            pg8::Unit u; have[i] = S.next(i, u); if (!have[i]) u = u0;
            const int row = 256 * (by_pn ? u.pn : u.pm) + (tid >> 1);
            const f32x4* p = (const f32x4*)(ssqp + (size_t)row * 16 + (tid & 1) * 8);
            a[i] = p[0]; b[i] = p[1];
        }
#pragma unroll
        for (int i = 0; i < MAXU; ++i) {
            float s = (a[i][0] + a[i][1]) + (a[i][2] + a[i][3]) + (b[i][0] + b[i][1]) + (b[i][2] + b[i][3]);
            s += __shfl_xor(s, 1);
            if (have[i] && !(tid & 1)) rs[i * 256 + (tid >> 1)] = rsqrtf(s * (1.f / D) + EPS);
        }
    }
    __syncthreads();
}

__device__ __forceinline__ void transpose_item(const float* W, int ldn, int k0, int n0, const float* gk, bf16_t* WT, int ldk, int drow0, LAS float* scr, int lane, const float* gn = nullptr) {
    const float gnv = gn ? gn[lane & 31] : 1.f;
    float wv[32];
#pragma unroll
    for (int i = 0; i < 32; ++i) wv[i] = W[(size_t)(k0 + 2 * i + (lane >> 5)) * ldn + n0 + (lane & 31)];
#pragma unroll
    for (int i = 0; i < 32; ++i) { const int kk = 2 * i + (lane >> 5); float v = wv[i] * gnv; if (gk) v *= gk[k0 + kk]; scr[kk * 33 + (lane & 31)] = v; }
    asm volatile("s_waitcnt lgkmcnt(0)" ::: "memory");
    const int c = lane & 7;
#pragma unroll
    for (int j = 0; j < 4; ++j) { const int n = (lane >> 3) + 8 * j; const LAS float* s = scr + (8 * c) * 33 + n;
        u32x4 o; o.x = cvt_pk_bf16(s[0 * 33], s[1 * 33]); o.y = cvt_pk_bf16(s[2 * 33], s[3 * 33]); o.z = cvt_pk_bf16(s[4 * 33], s[5 * 33]); o.w = cvt_pk_bf16(s[6 * 33], s[7 * 33]);
        *(u32x4*)(WT + (size_t)(drow0 + n) * ldk + k0 + 8 * c) = o; }
    asm volatile("s_waitcnt lgkmcnt(0)" ::: "memory");
}

struct Params {
    const float* x; const float* mix_norm; const float* ffn_norm; const float* pool_w; const float* pool_b; const float* pool_scale;
    const float* wqkv; const float* q_norm; const float* k_norm; const float* rel_bias; const float* wo;
    const float* w_gate; const float* w_val; const float* conv_w; const float* conv_b; const float* w_out;
    float* out; unsigned char* ws;
};

__device__ __forceinline__ void convert_weights(const Params& p, LAS unsigned char* lds, int gw, int NGW, int wave, int lane) {
    LAS float* scr = (LAS float*)(lds + wave * 16384);
    constexpr int I_POOL = 2 * 4 * (4 * 8);
    constexpr int I_QKV = 2 * (16 * 96);
    constexpr int I_WO = 2 * (16 * 32);
    constexpr int I_UP = 4 * 2 * (16 * 88);
    constexpr int I_OUT = 4 * (44 * 32);
    constexpr int NITEMS = I_POOL + I_QKV + I_WO + I_UP + I_OUT;
    for (int it = gw; it < NITEMS; it += NGW) {
        int r = it;
        if (r < I_POOL) {
            const int jg = r / 32, q = r % 32, kb = q / 8, nb = q % 8;
            transpose_item(p.pool_w + (size_t)jg * 65536, 256, 64 * kb, 32 * nb, nullptr, (bf16_t*)(p.ws + WS_POOLW) + (size_t)(jg >> 2) * 1024 * 256, 256, (jg & 3) * 256 + 32 * nb, scr, lane, p.pool_scale + (size_t)(jg >> 2) * D + (jg & 3) * 256 + 32 * nb);
            continue; }
        r -= I_POOL;
        if (r < I_QKV) {
            const int j = r / 1536, q = r % 1536, kb = q / 96, nb = q % 96, n0 = 32 * nb;
            const float* W = p.wqkv + (size_t)j * D * 3 * D; const float* gk = p.mix_norm + (size_t)(2 * j + 1) * D;
            if (n0 < 2048) { const int pn = n0 >> 8, nl = n0 & 255, wc = nl >> 6, dd = nl & 63, bj = dd >> 5;
                transpose_item(W, 3 * D, 64 * kb, n0, gk, (bf16_t*)(p.ws + WS_WQK) + (size_t)j * 2048 * D, D, 256 * pn + 128 * bj + 32 * wc, scr, lane); }
            else transpose_item(W, 3 * D, 64 * kb, n0, gk, (bf16_t*)(p.ws + WS_WVT) + (size_t)j * D * D, D, n0 - 2048, scr, lane);
            continue; }
        r -= I_QKV;
        if (r < I_WO) {
            const int j = r / 512, q = r % 512, kb = q / 32, nb = q % 32;
            transpose_item(p.wo + (size_t)j * D * D, D, 64 * kb, 32 * nb, nullptr, (bf16_t*)(p.ws + WS_WO) + (size_t)j * D * D, D, 32 * nb, scr, lane);
            continue; }
        r -= I_WO;
        if (r < I_UP) {
            const int i = r / 2816, q = r % 2816, isval = q / 1408, q2 = q % 1408, kb = q2 / 88, nb = q2 % 88, f0 = 32 * nb;
            const float* W = (isval ? p.w_val : p.w_gate) + (size_t)i * D * FF;
            transpose_item(W, FF, 64 * kb, f0, p.ffn_norm + (size_t)i * D, (bf16_t*)(p.ws + WS_WUP) + (size_t)i * 5632 * D, D, 256 * (f0 >> 7) + 128 * isval + (f0 & 127), scr, lane);
            continue; }
        r -= I_UP;
        {
            const int i = r / 1408, q = r % 1408, kb = q / 32, nb = q % 32;
            transpose_item(p.w_out + (size_t)i * FF * D, D, 64 * kb, 32 * nb, nullptr, (bf16_t*)(p.ws + WS_WOUT) + (size_t)i * D * FF, FF, 32 * nb, scr, lane);
        }
    }
}

template <bool IN_BF16> __device__ __forceinline__ void pool_prep(const void* xin_, const float* g, bf16_t* Y, LAS unsigned char* lds, int vcu, int G) {
    const float* xin = (const float*)xin_; const bf16_t* xinb = (const bf16_t*)xin_;
    LAS float* hs = (LAS float*)lds;
    int tid = threadIdx.x; asm volatile("" : "+v"(tid));
    const int lane = tid & 63, wave = tid >> 6;
    constexpr int RUN = 128;
    for (int run = vcu; run < M / RUN; run += G) {
        for (int k = 0; k < RUN / 16; ++k) {
            const int T0 = run * RUN + k * 16, ts0 = T0 & (SEQ - 1);
            const int nrow = (k == 0) ? 31 : 16, rbase = (k == 0) ? T0 - 15 : T0;
            {
                f32x4 v[4][4];
#pragma unroll
                for (int q = 0; q < 4; ++q) {
                    const int i = wave + 8 * q; const bool ok = (i < nrow) && (((rbase + i) & (SEQ - 1)) <= ts0 + 15) ;
                    const size_t rowo = (size_t)((i < nrow && rbase + i >= 0 && !(ts0 == 0 && k == 0 && i < 15)) ? rbase + i : T0) * D;
                    if (q < 2 || k == 0) {
                        if (IN_BF16) { const u32x2* xr = (const u32x2*)(xinb + rowo) + lane;
#pragma unroll
                            for (int j = 0; j < 4; ++j) { const u32x2 wv = xr[64 * j]; v[q][j] = (f32x4){bf_lo(wv.x), bf_hi(wv.x), bf_lo(wv.y), bf_hi(wv.y)}; } }
                        else { const f32x4* xr = (const f32x4*)(xin + rowo) + lane;
#pragma unroll
                            for (int j = 0; j < 4; ++j) v[q][j] = xr[64 * j]; }
                    }
                    (void)ok;
                }
#pragma unroll
                for (int q = 0; q < 4; ++q) {
                    const int i = wave + 8 * q;
                    if (i < nrow && (q < 2 || k == 0)) {
                        const int row = rbase + i;
                        LAS f32x4* hrow = (LAS f32x4*)(hs + (row & 31) * 1024) + lane;
                        float s = 0.f;
#pragma unroll
                        for (int j = 0; j < 4; ++j) s += (v[q][j][0] * v[q][j][0] + v[q][j][1] * v[q][j][1]) + (v[q][j][2] * v[q][j][2] + v[q][j][3] * v[q][j][3]);
                        float rstd = rsqrtf(wave_sum(s) * (1.f / D) + EPS);
                        if (ts0 == 0 && k == 0 && i < 15) rstd = 0.f;
#pragma unroll
                        for (int j = 0; j < 4; ++j) { const f32x4 gg = *((const f32x4*)g + lane + 64 * j); hrow[64 * j] = v[q][j] * rstd * gg; }
                    }
                }
            }
            __syncthreads();
            {
                const int c = 2 * tid, grp = c >> 8, w = 2 << grp;
                const LAS f32x2* hc = (const LAS f32x2*)(hs + c);
                f32x2 s = (f32x2){0.f, 0.f};
                for (int kk = 1; kk < w; ++kk) s += hc[((T0 - kk) & 31) * 512];
#pragma unroll 4
                for (int r = 0; r < 16; ++r) {
                    const f32x2 hv = hc[((T0 + r) & 31) * 512];
                    s += hv;
                    const int cnt = min(ts0 + r + 1, w);
                    const float ic = 1.f / (float)cnt;
                    const f32x2 y = s * ic - hv;
                    *(unsigned*)(Y + (size_t)(T0 + r) * D + c) = cvt_pk_bf16(y[0], y[1]);
                    s -= hc[((T0 + r - (w - 1)) & 31) * 512];
                }
            }
            __syncthreads();
        }
    }
}

__device__ __forceinline__ void conv_phase(const bf16_t* Ab, bf16_t* UV, const float* cw, const float* cb, int gthread, int nthreads) {
    constexpr int VC = FF / 8, NRUN = (M / 16) * VC;
    for (int run = gthread; run < NRUN; run += nthreads) {
        const int rb = run / VC, vc = run % VC, R0 = rb * 16, f0 = vc * 8;
        float w0[8], w1[8], w2[8], bb[8];
#pragma unroll
        for (int h = 0; h < 2; ++h) {
            const f32x4 a = *(const f32x4*)(cw + f0 + 4 * h), b = *(const f32x4*)(cw + FF + f0 + 4 * h), c = *(const f32x4*)(cw + 2 * FF + f0 + 4 * h), d = *(const f32x4*)(cb + f0 + 4 * h);
#pragma unroll
            for (int e = 0; e < 4; ++e) { w0[4 * h + e] = a[e]; w1[4 * h + e] = b[e]; w2[4 * h + e] = c[e]; bb[4 * h + e] = d[e]; }
        }
        float am2[8], am1[8];
        if ((R0 & (SEQ - 1)) == 0) {
#pragma unroll
            for (int e = 0; e < 8; ++e) { am2[e] = 0.f; am1[e] = 0.f; }
        } else {
            const u32x4 p2 = *(const u32x4*)(Ab + (size_t)(R0 - 2) * FF + f0), p1 = *(const u32x4*)(Ab + (size_t)(R0 - 1) * FF + f0);
#pragma unroll
            for (int e = 0; e < 4; ++e) { am2[2 * e] = bf_lo(p2[e]); am2[2 * e + 1] = bf_hi(p2[e]); am1[2 * e] = bf_lo(p1[e]); am1[2 * e + 1] = bf_hi(p1[e]); }
        }
#pragma unroll 4
        for (int r = 0; r < 16; ++r) {
            const size_t off = (size_t)(R0 + r) * FF + f0;
            const u32x4 pa = *(const u32x4*)(Ab + off), pv = *(const u32x4*)(UV + off);
            float a0[8], vv[8], o[8];
#pragma unroll
            for (int e = 0; e < 4; ++e) { a0[2 * e] = bf_lo(pa[e]); a0[2 * e + 1] = bf_hi(pa[e]); vv[2 * e] = bf_lo(pv[e]); vv[2 * e + 1] = bf_hi(pv[e]); }
#pragma unroll
            for (int e = 0; e < 8; ++e) {
                const float c = am2[e] * w0[e] + am1[e] * w1[e] + a0[e] * w2[e] + bb[e];
                const float sg = __builtin_amdgcn_rcpf(1.f + __builtin_amdgcn_exp2f(-c * LOG2E));
                o[e] = c * sg * vv[e];
                am2[e] = am1[e]; am1[e] = a0[e];
            }
            u32x4 pk; pk.x = cvt_pk_bf16(o[0], o[1]); pk.y = cvt_pk_bf16(o[2], o[3]); pk.z = cvt_pk_bf16(o[4], o[5]); pk.w = cvt_pk_bf16(o[6], o[7]);
            *(u32x4*)(UV + off) = pk;
        }
    }
}

__device__ __forceinline__ int crow(int r, int hi) { return (r & 3) + 8 * (r >> 2) + 4 * hi; }
constexpr int KS_PITCH = 144, VS_PITCH = 136, KS_TILE = 64 * KS_PITCH, VS_TILE = 64 * VS_PITCH;
constexpr int ATT_KS = 0, ATT_VS = 4 * KS_TILE, ATT_TB = ATT_VS + 4 * VS_TILE, TB_COPY = 656, ATT_RED = ATT_TB + 2 * 4 * TB_COPY * 4;
static_assert(ATT_RED + 128 <= RING_BYTES && ATT_TB % 16 == 0, "attention LDS map");

__device__ __forceinline__ void attn_phase(LAS unsigned char* lds, const bf16_t* Q, const bf16_t* Kb, const bf16_t* Vt, bf16_t* O, const float* relb, const float* qn, const float* kn, int vcu, int G) {
    int tid = threadIdx.x; asm volatile("" : "+v"(tid));
    const int lane = tid & 63, r32 = lane & 31, hi = lane >> 5, w = __builtin_amdgcn_readfirstlane(tid >> 6), cw = w >> 1, half = w >> 2;
    int cached0 = -1, cached1 = -1;
    float mqk; { float a = fabsf(qn[lane]), b = fabsf(kn[lane]);
#pragma unroll
        for (int o = 1; o < 64; o <<= 1) { a = fmaxf(a, __shfl_xor(a, o)); b = fmaxf(b, __shfl_xor(b, o)); }
        mqk = a * b; }
    const int iq = 32 * (w & 1) + r32;
    const int cpy = (4 - (iq & 3)) & 3;
    const int tb_lane = cpy * (TB_COPY * 4) + (4 * hi + 64 - iq - cpy) * 4;
    const int lr = tid >> 3, pc = tid & 7;
#define ATT_BAR() do { asm volatile("s_waitcnt lgkmcnt(0)" ::: "memory"); __builtin_amdgcn_s_barrier(); asm volatile("" ::: "memory"); } while (0)
#define ATT_LD(j, KR, VR) do { KR = *(const u32x4*)(Kb + (kg0 + (long)(j) * 64 * D)); VR = *(const u32x4*)(Vt + (vg0 + (long)(j) * 64)); } while (0)
#define ATT_ST(j, KR, VR) do { LAS unsigned char* kd_ = lds + ATT_KS + ((j) & 3) * KS_TILE + lr * KS_PITCH + pc * 16; LAS unsigned char* vd_ = lds + ATT_VS + ((j) & 3) * VS_TILE + lr * VS_PITCH + pc * 16; \
        *(LAS u32x4*)kd_ = KR; *(LAS u32x2*)vd_ = (u32x2){VR.x, VR.y}; *(LAS u32x2*)(vd_ + 8) = (u32x2){VR.z, VR.w}; } while (0)
#define ATT_QK(j, bc, P0, P1) do { const LAS unsigned char* ks_ = lds + ATT_KS + ((j) & 3) * KS_TILE + r32 * KS_PITCH + hi * 16; \
        { const LAS unsigned char* tp_ = (const LAS unsigned char*)tbl + (tb_lane + 256 * (bc)); \
            _Pragma("unroll") for (int g_ = 0; g_ < 4; ++g_) { const f32x4 t0_ = *(const LAS f32x4*)(tp_ + 32 * g_), t1_ = *(const LAS f32x4*)(tp_ + 32 * g_ + 128); \
                _Pragma("unroll") for (int e = 0; e < 4; ++e) { P0[4 * g_ + e] = t0_[e]; P1[4 * g_ + e] = t1_[e]; } } } \
        _Pragma("unroll") for (int d0 = 0; d0 < 4; ++d0) { \
            const bf16x8 a0_ = *(const LAS bf16x8*)(ks_ + d0 * 32), a1_ = *(const LAS bf16x8*)(ks_ + 32 * KS_PITCH + d0 * 32); \
            P0 = __builtin_amdgcn_mfma_f32_32x32x16_bf16(a0_, qr[d0], P0, 0, 0, 0); P1 = __builtin_amdgcn_mfma_f32_32x32x16_bf16(a1_, qr[d0], P1, 0, 0, 0); } } while (0)
#define ATT_SM(P0, P1, PW) do { \
        float ls0_ = 0.f, ls1_ = 0.f; \
        _Pragma("unroll") for (int r = 0; r < 16; ++r) { P0[r] = __builtin_amdgcn_exp2f(P0[r]); P1[r] = __builtin_amdgcn_exp2f(P1[r]); ls0_ += P0[r]; ls1_ += P1[r]; } \
        lrun += ls0_ + ls1_; \
        _Pragma("unroll") for (int s2 = 0; s2 < 2; ++s2) { \
            u32x4 t_; t_.x = cvt_pk_bf16(P0[8 * s2 + 0], P0[8 * s2 + 1]); t_.y = cvt_pk_bf16(P0[8 * s2 + 2], P0[8 * s2 + 3]); t_.z = cvt_pk_bf16(P0[8 * s2 + 4], P0[8 * s2 + 5]); t_.w = cvt_pk_bf16(P0[8 * s2 + 6], P0[8 * s2 + 7]); \
            PW[s2] = __builtin_bit_cast(bf16x8, t_); \
            u32x4 t2_; t2_.x = cvt_pk_bf16(P1[8 * s2 + 0], P1[8 * s2 + 1]); t2_.y = cvt_pk_bf16(P1[8 * s2 + 2], P1[8 * s2 + 3]); t2_.z = cvt_pk_bf16(P1[8 * s2 + 4], P1[8 * s2 + 5]); t2_.w = cvt_pk_bf16(P1[8 * s2 + 6], P1[8 * s2 + 7]); \
            PW[2 + s2] = __builtin_bit_cast(bf16x8, t2_); } } while (0)
#define ATT_PV(j, PW) do { const LAS unsigned char* vs_ = lds + ATT_VS + ((j) & 3) * VS_TILE + r32 * VS_PITCH + hi * 8; \
        _Pragma("unroll") for (int s2 = 0; s2 < 4; ++s2) { \
            const s16x4 l0_ = *(const LAS s16x4*)(vs_ + s2 * 32), h0_ = *(const LAS s16x4*)(vs_ + s2 * 32 + 16); \
            const s16x4 l1_ = *(const LAS s16x4*)(vs_ + 32 * VS_PITCH + s2 * 32), h1_ = *(const LAS s16x4*)(vs_ + 32 * VS_PITCH + s2 * 32 + 16); \
            const bf16x8 va0_ = (bf16x8){l0_[0], l0_[1], l0_[2], l0_[3], h0_[0], h0_[1], h0_[2], h0_[3]}; \
            const bf16x8 va1_ = (bf16x8){l1_[0], l1_[1], l1_[2], l1_[3], h1_[0], h1_[1], h1_[2], h1_[3]}; \
            o0 = __builtin_amdgcn_mfma_f32_32x32x16_bf16(va0_, PW[s2], o0, 0, 0, 0); o1 = __builtin_amdgcn_mfma_f32_32x32x16_bf16(va1_, PW[s2], o1, 0, 0, 0); } } while (0)
    for (int U = vcu; U < BATCH * NH * (SEQ / 256); U += G) {
        const int bh = U >> 5, qb = U & 31, b = bh >> 4, h = bh & 15;
        const size_t rowbase = (size_t)b * SEQ;
        const int slot = h >> 3;
        LAS float* tbl = (LAS float*)(lds + ATT_TB) + slot * (4 * TB_COPY); LAS float* red = (LAS float*)(lds + ATT_RED) + slot * 8;
        __syncthreads();
        if ((slot ? cached1 : cached0) != h) {
            float mb = fabsf(relb[h * 513 + tid]); if (tid == 0) mb = fmaxf(mb, fabsf(relb[h * 513 + 512]));
#pragma unroll
            for (int o = 1; o < 64; o <<= 1) mb = fmaxf(mb, __shfl_xor(mb, o));
            if (lane == 0) red[w] = mb;
            __syncthreads();
            mb = red[0];
#pragma unroll
            for (int i = 1; i < 8; ++i) mb = fmaxf(mb, red[i]);
            const float negB = -(1.02f * 8.f * LOG2E * mqk + LOG2E * mb + 0.1f);
            for (int i = tid; i < 4 * TB_COPY; i += 512) { const int c = i / TB_COPY, z = i % TB_COPY + c; tbl[i] = relb[h * 513 + (z < 320 ? 512 : (z <= 832 ? 832 - z : 0))] * LOG2E + negB; }
            if (slot) cached1 = h; else cached0 = h;
        }
        const int jlo = (qb < 2) ? 8 - 4 * qb : 0;
        const long kg0 = ((long)rowbase + (long)(4 * qb - 8) * 64 + lr) * D + h * 64 + pc * 8;
        const long vg0 = (long)(h * 64 + lr) * M + (long)rowbase + (long)(4 * qb - 8) * 64 + pc * 8;
        u32x4 kreg, vreg;
        { u32x4 ka, va, kb2, vb2; ATT_LD(jlo, ka, va); ATT_LD(jlo + 1, kb2, vb2); ATT_LD(jlo + 2, kreg, vreg);
          ATT_ST(jlo, ka, va); ATT_ST(jlo + 1, kb2, vb2); }
        bf16x8 qr[4];
        { const bf16_t* qp = Q + (rowbase + (size_t)qb * 256 + w * 32 + r32) * D + h * 64 + hi * 8;
#pragma unroll
          for (int d0 = 0; d0 < 4; ++d0) qr[d0] = *(const bf16x8*)(qp + d0 * 16); }
        __syncthreads();
        float lrun = 0.f; f32x16 o0 = {}, o1 = {}, sc0 = {}, sc1 = {}; bf16x8 pw[4] = {};
        if (half == 1) ATT_BAR();
        for (int g = jlo; g <= 12; ++g) {
            const int bcg = g - cw, bcp = bcg - 1;
            const bool actg = (g <= 11) && bcg >= 0 && bcg <= 8, actp = (g - 1 >= jlo) && bcp >= 0 && bcp <= 8;
            if (actg) ATT_QK(g, bcg, sc0, sc1);
            if (actp) ATT_PV(g - 1, pw);
            ATT_BAR();
            if (g + 2 <= 11) ATT_ST(g + 2, kreg, vreg);
            if (g + 3 <= 11) ATT_LD(g + 3, kreg, vreg);
            if (actg) ATT_SM(sc0, sc1, pw);
            ATT_BAR();
        }
        if (half == 0) ATT_BAR();
        const float lt = lrun + __shfl_xor(lrun, 32), il = 1.f / lt;
        bf16_t* op = O + (rowbase + (size_t)qb * 256 + w * 32 + r32) * D + h * 64 + 4 * hi;
#pragma unroll
        for (int gq = 0; gq < 4; ++gq) {
            u32x2 a; a.x = cvt_pk_bf16(o0[4 * gq] * il, o0[4 * gq + 1] * il); a.y = cvt_pk_bf16(o0[4 * gq + 2] * il, o0[4 * gq + 3] * il);
            u32x2 c; c.x = cvt_pk_bf16(o1[4 * gq] * il, o1[4 * gq + 1] * il); c.y = cvt_pk_bf16(o1[4 * gq + 2] * il, o1[4 * gq + 3] * il);
            *(u32x2*)(op + 8 * gq) = a; *(u32x2*)(op + 32 + 8 * gq) = c;
        }
    }
#undef ATT_BAR
#undef ATT_LD
#undef ATT_ST
#undef ATT_QK
#undef ATT_SM
#undef ATT_PV
    __syncthreads();
}

#define XB_TMO      128
#define XB_XCNT(j)  (256  + 64 * (j))
#define XB_XSUB(j)  (1280 + 64 * (j))
#define XB_XGEN(j)  (2304 + 64 * (j))
#define XB_TOP      3328
#define XB_TOPGEN   3392
#define XCD_BAR_WORDS 3456
#define XB_SPIN_CAP (1u << 18)

__device__ __forceinline__ unsigned xb_ld(unsigned* p)              { return __hip_atomic_load(p, __ATOMIC_RELAXED, __HIP_MEMORY_SCOPE_AGENT); }
__device__ __forceinline__ unsigned xb_add(unsigned* p, unsigned v) { return __hip_atomic_fetch_add(p, v, __ATOMIC_RELAXED, __HIP_MEMORY_SCOPE_AGENT); }
__device__ __forceinline__ unsigned xb_xcc_id() { return (unsigned)__builtin_amdgcn_s_getreg((3 << 11) | 20) & 0xFu; }
#define XB_SPIN(cond, bar) do { unsigned _sp = 0; while (cond) { __builtin_amdgcn_s_sleep(1); \
    if ((++_sp & 255u) == 0u) { if (xb_ld(&(bar)[XB_TMO])) break; if (_sp > XB_SPIN_CAP) { atomicAdd(&(bar)[XB_TMO], 1u); break; } } } } while (0)

struct XcdBarrier {
    unsigned* bar; unsigned x;
    volatile LAS unsigned* st;
};

__device__ __forceinline__ XcdBarrier xcd_barrier_post(unsigned* bar, volatile LAS unsigned* st) {
    XcdBarrier b; b.bar = bar; b.x = xb_xcc_id(); b.st = st;
    if (threadIdx.x == 0) (void)xb_add(&bar[XB_XCNT(b.x)], 1u);
    return b;
}
__device__ __forceinline__ void xcd_barrier_complete(unsigned* bar, unsigned x, unsigned& nloc, unsigned& nx) {
    const unsigned G = gridDim.x * gridDim.y * gridDim.z;
    unsigned sum, cnt, mine, sp = 0u;
    for (;;) {
        sum = 0u; cnt = 0u; mine = 0u;
#pragma unroll
        for (unsigned j = 0; j < 16; ++j) { const unsigned c = xb_ld(&bar[XB_XCNT(j)]); sum += c; cnt += (c > 0u) ? 1u : 0u; mine = (j == x) ? c : mine; }
        if (sum == G) break;
        __builtin_amdgcn_s_sleep(1);
        if ((++sp & 255u) == 0u) { if (xb_ld(&bar[XB_TMO])) break; if (sp > XB_SPIN_CAP) { atomicAdd(&bar[XB_TMO], 1u); break; } }
    }
    nloc = mine > 0u ? mine : 1u; nx = cnt > 0u ? cnt : 1u;
}

__device__ __forceinline__ void xcd_barrier(const XcdBarrier& b) {
    asm volatile("s_waitcnt vmcnt(0)" ::: "memory");
    __syncthreads();
    if (threadIdx.x == 0) {
        unsigned* bar = b.bar;
        __builtin_amdgcn_s_waitcnt(0);
        unsigned nloc = b.st[0], nx = b.st[1];
        if (nloc == 0u) { xcd_barrier_complete(bar, b.x, nloc, nx); b.st[0] = nloc; b.st[1] = nx; }
        const unsigned old = xb_add(&bar[XB_XSUB(b.x)], 1u);
        const unsigned gen = old / nloc;
        if (old + 1u == (gen + 1u) * nloc) {
            __builtin_amdgcn_fence(__ATOMIC_RELEASE, "agent");
            asm volatile("s_waitcnt vmcnt(0)" ::: "memory");
            const unsigned og = xb_add(&bar[XB_TOP], 1u);
            const unsigned tg = og / nx;
            if (og + 1u == (tg + 1u) * nx) xb_add(&bar[XB_TOPGEN], 1u);
            else XB_SPIN(xb_ld(&bar[XB_TOPGEN]) == tg, bar);
            __builtin_amdgcn_fence(__ATOMIC_ACQUIRE, "agent");
            xb_add(&bar[XB_XGEN(b.x)], 1u);
            asm volatile("s_waitcnt vmcnt(0)" ::: "memory");
        } else {
            XB_SPIN(xb_ld(&bar[XB_XGEN(b.x)]) == gen, bar);
            __builtin_amdgcn_fence(__ATOMIC_ACQUIRE, "agent");
            asm volatile("s_waitcnt vmcnt(0)" ::: "memory");
        }
    }
    __syncthreads();
}

__global__ void __launch_bounds__(512, 2) fwd_megakernel(Params p) {
    extern __shared__ __attribute__((aligned(16))) unsigned char lds_raw[];
    LAS unsigned char* lds = (LAS unsigned char*)lds_raw;
    LAS float* rs = (LAS float*)(lds + RS_OFF);
    cg::grid_group grid = cg::this_grid();
    { volatile LAS unsigned* misc = (volatile LAS unsigned*)(lds + MISC_OFF); if (threadIdx.x < 2) misc[threadIdx.x] = 0u; }
    __syncthreads();
    const XcdBarrier bar = xcd_barrier_post((unsigned*)(p.ws + WS_CTL), (volatile LAS unsigned*)(lds + MISC_OFF));
    int tid = threadIdx.x; asm volatile("" : "+v"(tid));
    const int lane = tid & 63, wave = __builtin_amdgcn_readfirstlane(tid >> 6);
    const int G = gridDim.x, bx = blockIdx.x;
    const int vcu = (G % 8 == 0) ? (bx % 8) * (G / 8) + bx / 8 : bx;
    unsigned char* ws = p.ws;
    bf16_t* XB = (bf16_t*)(ws + WS_XB); float* SSQ = (float*)(ws + WS_SSQ);

    convert_weights(p, lds, vcu * 8 + wave, G * 8, wave, lane);
    __syncthreads();
    pool_prep<false>(p.x, p.mix_norm, (bf16_t*)(ws + WS_Y), lds, vcu, G);
    if (gridDim.y == 0x7fffffffu) grid.sync();
    xcd_barrier(bar);

    for (int layer = 0; layer < DEPTH; ++layer) {
        const int j = layer >> 1;
        for (int sub = 0; sub < 2; ++sub) {
            pg8::Gemm g; int N_ = D; bool affine = false; const float* ebias = nullptr; const float* escale = nullptr;
            if (sub == 0) {
                if ((layer & 1) == 0) {
                    if (layer > 0) { pool_prep<true>(XB, p.mix_norm + (size_t)layer * D, (bf16_t*)(ws + WS_Y), lds, vcu, G); xcd_barrier(bar); }
                    g = pg8::Gemm{(const bf16_t*)(ws + WS_Y), (const bf16_t*)(ws + WS_POOLW) + (size_t)j * 1024 * 256, 256, D, 256, 256};
                    ebias = p.pool_b + (size_t)j * D; escale = p.pool_scale + (size_t)j * D; affine = true;
                } else {
                    {
                        pg8::StaticOrder S; S.init(M, 2048, G, bx);
                        fill_rstd<4>(rs, SSQ, S, false);
                        pg8::Gemm gq{XB, (const bf16_t*)(ws + WS_WQK) + (size_t)j * 2048 * D, D, D, D, 0};
                        EpiQK Eq{(bf16_t*)(ws + WS_Q), (bf16_t*)(ws + WS_K), p.q_norm + j * 64, p.k_norm + j * 64, rs};
                        pg8::gemm_phase<EpiQK, pg8::StaticOrder>(lds, gq, S, Eq);
                    }
                    {
                        pg8::StaticOrder S; S.init(D, M, G, bx);
                        fill_rstd<2>(rs, SSQ, S, true);
                        pg8::Gemm gv{(const bf16_t*)(ws + WS_WVT) + (size_t)j * D * D, XB, D, D, D, 0};
                        EpiVt Ev{(bf16_t*)(ws + WS_VT), rs};
                        pg8::gemm_phase<EpiVt, pg8::StaticOrder>(lds, gv, S, Ev);
                    }
                    xcd_barrier(bar);
                    attn_phase(lds, (const bf16_t*)(ws + WS_Q), (const bf16_t*)(ws + WS_K), (const bf16_t*)(ws + WS_VT), (bf16_t*)(ws + WS_O), p.rel_bias + (size_t)j * NH * 513, p.q_norm + j * 64, p.k_norm + j * 64, vcu, G);
                    xcd_barrier(bar);
                    g = pg8::Gemm{(const bf16_t*)(ws + WS_O), (const bf16_t*)(ws + WS_WO) + (size_t)j * D * D, D, D, D, 0};
                }
            } else {
                {
                    pg8::StaticOrder S; S.init(M, 2 * FF, G, bx);
                    fill_rstd<11>(rs, SSQ, S, false);
                    pg8::Gemm gu{XB, (const bf16_t*)(ws + WS_WUP) + (size_t)layer * 5632 * D, D, D, D, 0};
                    EpiUpConv Eu{(bf16_t*)(ws + WS_UBUF), rs, (LAS float*)(lds + XCH_OFF), p.conv_w + (size_t)layer * 3 * FF, p.conv_b + (size_t)layer * FF, (float*)(ws + WS_BOT), (float*)(ws + WS_TOPA), (float*)(ws + WS_TOPV)};
                    pg8::gemm_phase<EpiUpConv, pg8::StaticOrder>(lds, gu, S, Eu);
                }
                xcd_barrier(bar);
                {   pg8::StaticOrder S; S.init(M, D, G, bx);
                    conv_fixup(S, (bf16_t*)(ws + WS_UBUF), (const float*)(ws + WS_BOT), (const float*)(ws + WS_TOPA), (const float*)(ws + WS_TOPV), p.conv_w + (size_t)layer * 3 * FF, p.conv_b + (size_t)layer * FF); }
                g = pg8::Gemm{(const bf16_t*)(ws + WS_UBUF), (const bf16_t*)(ws + WS_WOUT) + (size_t)layer * D * FF, FF, FF, FF, 0};
            }
            {
                pg8::StaticOrder S; S.init(M, N_, G, bx);
                if (affine && layer == 0) { EpiRes<true, true, false> Ea{p.x, nullptr, XB, SSQ, ebias, escale}; pg8::gemm_phase<EpiRes<true, true, false>, pg8::StaticOrder>(lds, g, S, Ea); }
                else if (affine) { EpiRes<true, false, false> Ea{nullptr, nullptr, XB, SSQ, ebias, escale}; pg8::gemm_phase<EpiRes<true, false, false>, pg8::StaticOrder>(lds, g, S, Ea); }
                else if (layer == DEPTH - 1 && sub == 1) { EpiRes<false, false, true> Ea{nullptr, p.out, XB, SSQ, nullptr, nullptr}; pg8::gemm_phase<EpiRes<false, false, true>, pg8::StaticOrder>(lds, g, S, Ea); }
                else { EpiRes<false, false, false> Ea{nullptr, nullptr, XB, SSQ, nullptr, nullptr}; pg8::gemm_phase<EpiRes<false, false, false>, pg8::StaticOrder>(lds, g, S, Ea); }
            }
            if (!(layer == DEPTH - 1 && sub == 1)) xcd_barrier(bar);
        }
    }
}

extern "C" void kernel_launch(void* const* d_in, const int* in_sizes, int n_in, void* d_out, int out_size, void* d_ws, size_t ws_size, hipStream_t stream) {
    static int grid = 0;
    if (grid == 0) {
        if (n_in != 16 || in_sizes[0] != M * D || out_size != M * D || ws_size < WS_END) { fprintf(stderr, "kernel_launch: unexpected shapes / workspace (n_in %d, ws %zu, need %zu)\n", n_in, ws_size, (size_t)WS_END); grid = -1; return; }
        int dev = 0, cus = 0, per_cu = 0;
        hipGetDevice(&dev);
        hipDeviceGetAttribute(&cus, hipDeviceAttributeMultiprocessorCount, dev);
        if (hipFuncSetAttribute((const void*)fwd_megakernel, hipFuncAttributeMaxDynamicSharedMemorySize, LDS_BYTES) != hipSuccess) { fprintf(stderr, "kernel_launch: hipFuncSetAttribute failed\n"); grid = -1; return; }
        if (hipOccupancyMaxActiveBlocksPerMultiprocessor(&per_cu, (const void*)fwd_megakernel, 512, LDS_BYTES) != hipSuccess || per_cu < 1) { fprintf(stderr, "kernel_launch: occupancy query failed (%d)\n", per_cu); per_cu = 1; }
        (void)hipGetLastError();
        grid = cus * per_cu;
        if (grid > 256) grid = 256;
        fprintf(stderr, "kernel_launch: grid %d (cus %d x %d)\n", grid, cus, per_cu);
    }
    if (grid < 0) return;
    Params p{};
    p.x = (const float*)d_in[0]; p.mix_norm = (const float*)d_in[1]; p.ffn_norm = (const float*)d_in[2]; p.pool_w = (const float*)d_in[3]; p.pool_b = (const float*)d_in[4];
    p.pool_scale = (const float*)d_in[5]; p.wqkv = (const float*)d_in[6]; p.q_norm = (const float*)d_in[7]; p.k_norm = (const float*)d_in[8]; p.rel_bias = (const float*)d_in[9];
    p.wo = (const float*)d_in[10]; p.w_gate = (const float*)d_in[11]; p.w_val = (const float*)d_in[12]; p.conv_w = (const float*)d_in[13]; p.conv_b = (const float*)d_in[14]; p.w_out = (const float*)d_in[15];
    p.out = (float*)d_out; p.ws = (unsigned char*)d_ws;
    if (hipMemsetAsync((char*)d_ws + WS_CTL, 0, CTL_BYTES, stream) != hipSuccess) { fprintf(stderr, "kernel_launch: hipMemsetAsync failed\n"); return; }
    void* args[] = {&p};
    hipError_t e = hipLaunchCooperativeKernel((const void*)fwd_megakernel, dim3(grid), dim3(512), args, LDS_BYTES, stream);
    if (e != hipSuccess) fprintf(stderr, "kernel_launch: cooperative launch failed: %s (grid %d)\n", hipGetErrorString(e), grid);
}
```
